# Optimizing an MI355X kernel written in HIP

```python
import jax, jax.numpy as jnp
from jax import lax
import numpy as np

D_MODEL = 1024
BATCH = 4
SEQ = 8192
DEPTH = 2

CHUNK = 64
Q_BLOCK = 128
FOX_HEADS = 8
FOX_HEAD_DIM = 64
FOX_WIDTH = FOX_HEADS * FOX_HEAD_DIM
POOL_WINDOWS = (2, 4, 8, 16)
POOL_GROUPS = len(POOL_WINDOWS)
POOL_WIDTH = D_MODEL - FOX_WIDTH
POOL_GROUP_DIM = POOL_WIDTH // POOL_GROUPS
EVEN_IN_WIDTH = 3 * FOX_WIDTH + FOX_HEADS + POOL_WIDTH
LRU_WIDTH = D_MODEL
LRU_HEADS = 4
LRU_HEAD_DIM = LRU_WIDTH // LRU_HEADS
CONV_WIDTH = 4
LRU_C = 8.0
D_FF = -(-8 * D_MODEL // (3 * 256)) * 256
RMS_EPS = 1e-6

kernel_name = "fox_pool_rglru_hybrid_trunk"


def rmsnorm(x, g):
    xf = x.astype(jnp.float32)
    y = xf * lax.rsqrt(jnp.mean(xf * xf, axis=-1, keepdims=True) + RMS_EPS)
    return (y * g.astype(jnp.float32)).astype(x.dtype)


def swiglu(h, w_gate, w_up, w_down):
    return (jax.nn.silu(h @ w_gate) * (h @ w_up)) @ w_down


def forgetting_attention(q, k, v, log_f):
    B, S, H, Dh = q.shape
    n_blk = S // Q_BLOCK
    scale = Dh ** -0.5
    c = jnp.cumsum(log_f, axis=1).transpose(0, 2, 1)
    q_blocks = q.reshape(B, n_blk, Q_BLOCK, H, Dh).transpose(1, 0, 3, 2, 4)
    c_blocks = c.reshape(B, H, n_blk, Q_BLOCK).transpose(2, 0, 1, 3)
    k_pos = jnp.arange(S, dtype=jnp.int32)

    def one_block(args):
        qb, cb, i = args
        s = jnp.einsum('bhqd,bshd->bhqs', qb, k, preferred_element_type=jnp.float32)
        s = s * scale + cb[..., None] - c[:, :, None, :]
        q_pos = i * Q_BLOCK + jnp.arange(Q_BLOCK, dtype=jnp.int32)
        mask = k_pos[None, :] <= q_pos[:, None]
        s = jnp.where(mask, s, -jnp.inf)
        p = jax.nn.softmax(s, axis=-1)
        return jnp.einsum('bhqs,bshd->bqhd', p.astype(v.dtype), v)

    out = lax.map(one_block, (q_blocks, c_blocks, jnp.arange(n_blk, dtype=jnp.int32)))
    return out.transpose(1, 0, 2, 3, 4).reshape(B, S, H * Dh)


def multiscale_pool(u, pool_w, pool_scale):
    B, S, _ = u.shape
    uf = u.astype(jnp.float32).reshape(B, S, POOL_GROUPS, POOL_GROUP_DIM)
    cs = jnp.cumsum(uf, axis=1)
    t1 = jnp.arange(1, S + 1, dtype=jnp.float32)
    pooled = []
    for g, w in enumerate(POOL_WINDOWS):
        cg = cs[:, :, g]
        lagged = jnp.pad(cg, ((0, 0), (w, 0), (0, 0)))[:, :S]
        mean = (cg - lagged) / jnp.minimum(t1, float(w))[None, :, None]
        pooled.append(mean - uf[:, :, g])
    pooled = jnp.stack(pooled, axis=2)
    mixed = jnp.einsum('bsgd,gde->bsge', pooled, pool_w.astype(jnp.float32))
    return (mixed.reshape(B, S, POOL_WIDTH) * pool_scale.astype(jnp.float32)).astype(u.dtype)


def even_mixer(h, w_in, b_f, pool_w, pool_scale, w_out):
    B, S, _ = h.shape
    proj = h @ w_in
    q, k, v, f_logit, u = jnp.split(
        proj, [FOX_WIDTH, 2 * FOX_WIDTH, 3 * FOX_WIDTH, 3 * FOX_WIDTH + FOX_HEADS], axis=-1)
    q = q.reshape(B, S, FOX_HEADS, FOX_HEAD_DIM)
    k = k.reshape(B, S, FOX_HEADS, FOX_HEAD_DIM)
    v = v.reshape(B, S, FOX_HEADS, FOX_HEAD_DIM)
    log_f = jax.nn.log_sigmoid(f_logit.astype(jnp.float32) + b_f.astype(jnp.float32))
    attn = forgetting_attention(q, k, v, log_f)
    pool = multiscale_pool(u, pool_w, pool_scale)
    return jnp.concatenate([attn, pool.astype(attn.dtype)], axis=-1) @ w_out


def causal_depthwise_conv(x, conv_w, conv_b):
    C = x.shape[-1]
    y = lax.conv_general_dilated(
        x, conv_w[:, None, :], window_strides=(1,), padding=[(CONV_WIDTH - 1, 0)],
        dimension_numbers=('NWC', 'WIO', 'NWC'), feature_group_count=C)
    return y + conv_b


def rg_lru(x, w_a, b_a, w_x, b_x, lam):
    B, S, W = x.shape
    xf = x.astype(jnp.float32)
    xh = xf.reshape(B, S, LRU_HEADS, LRU_HEAD_DIM)
    r = jax.nn.sigmoid(jnp.einsum('bshd,hde->bshe', xh, w_a.astype(jnp.float32)).reshape(B, S, W)
                       + b_a.astype(jnp.float32))
    i = jax.nn.sigmoid(jnp.einsum('bshd,hde->bshe', xh, w_x.astype(jnp.float32)).reshape(B, S, W)
                       + b_x.astype(jnp.float32))
    log_a = -LRU_C * r * jax.nn.softplus(-lam.astype(jnp.float32))
    a = jnp.exp(log_a)
    b = jnp.sqrt(-jnp.expm1(2.0 * log_a)) * (i * xf)

    def combine(c1, c2):
        a1, b1 = c1
        a2, b2 = c2
        return a1 * a2, a2 * b1 + b2

    _, hs = lax.associative_scan(combine, (a, b), axis=1)
    return hs.astype(x.dtype)


def odd_mixer(h, w_in, conv_w, conv_b, w_a, b_a, w_x, b_x, lam, w_out):
    proj = h @ w_in
    gate, xr = jnp.split(proj, 2, axis=-1)
    xr = causal_depthwise_conv(xr, conv_w, conv_b)
    y = rg_lru(xr, w_a, b_a, w_x, b_x, lam)
    return (jax.nn.gelu(gate) * y) @ w_out


def setup_inputs(seed: int = 0) -> dict:
    key = jax.random.key(seed)
    ks = jax.random.split(key, 32)
    f32 = jnp.float32
    ne = (DEPTH + 1) // 2
    no = DEPTH // 2

    def nrm(k, shape, scale):
        return jax.random.normal(k, shape, f32) * scale

    def gain(k, shape):
        return 1.0 + 0.05 * jax.random.normal(k, shape, f32)

    u = jax.random.uniform(ks[24], (no, LRU_WIDTH), f32, minval=0.9, maxval=0.999)
    s = u ** (1.0 / LRU_C)
    lam = jnp.log(s) - jnp.log1p(-s)
    return {
        "x": jax.random.normal(ks[0], (BATCH, SEQ, D_MODEL), f32),
        "mix_pre_g": gain(ks[1], (DEPTH, D_MODEL)),
        "mix_post_g": gain(ks[2], (DEPTH, D_MODEL)),
        "ffn_pre_g": gain(ks[3], (DEPTH, D_MODEL)),
        "ffn_post_g": gain(ks[4], (DEPTH, D_MODEL)),
        "ffn_w_gate": nrm(ks[5], (DEPTH, D_MODEL, D_FF), D_MODEL ** -0.5),
        "ffn_w_up": nrm(ks[6], (DEPTH, D_MODEL, D_FF), D_MODEL ** -0.5),
        "ffn_w_down": nrm(ks[7], (DEPTH, D_FF, D_MODEL), D_FF ** -0.5),
        "ev_w_in": nrm(ks[8], (ne, D_MODEL, EVEN_IN_WIDTH), D_MODEL ** -0.5),
        "ev_b_f": jax.random.uniform(ks[9], (ne, FOX_HEADS), f32, minval=1.0, maxval=6.0),
        "ev_pool_w": nrm(ks[10], (ne, POOL_GROUPS, POOL_GROUP_DIM, POOL_GROUP_DIM), POOL_GROUP_DIM ** -0.5),
        "ev_pool_scale": 1.0 + 0.1 * jax.random.normal(ks[11], (ne, POOL_WIDTH), f32),
        "ev_w_out": nrm(ks[12], (ne, D_MODEL, D_MODEL), D_MODEL ** -0.5),
        "od_w_in": nrm(ks[13], (no, D_MODEL, 2 * LRU_WIDTH), D_MODEL ** -0.5),
        "od_conv_w": nrm(ks[14], (no, CONV_WIDTH, LRU_WIDTH), CONV_WIDTH ** -0.5),
        "od_conv_b": nrm(ks[15], (no, LRU_WIDTH), 0.01),
        "od_w_a": nrm(ks[16], (no, LRU_HEADS, LRU_HEAD_DIM, LRU_HEAD_DIM), LRU_HEAD_DIM ** -0.5),
        "od_b_a": nrm(ks[17], (no, LRU_WIDTH), 0.01),
        "od_w_x": nrm(ks[18], (no, LRU_HEADS, LRU_HEAD_DIM, LRU_HEAD_DIM), LRU_HEAD_DIM ** -0.5),
        "od_b_x": nrm(ks[19], (no, LRU_WIDTH), 0.01),
        "od_lam": lam,
        "od_w_out": nrm(ks[20], (no, LRU_WIDTH, D_MODEL), LRU_WIDTH ** -0.5),
    }


def reference(x, mix_pre_g, mix_post_g, ffn_pre_g, ffn_post_g, ffn_w_gate, ffn_w_up, ffn_w_down,
              ev_w_in, ev_b_f, ev_pool_w, ev_pool_scale, ev_w_out,
              od_w_in, od_conv_w, od_conv_b, od_w_a, od_b_a, od_w_x, od_b_x, od_lam, od_w_out):
    for layer in range(DEPTH):
        h = rmsnorm(x, mix_pre_g[layer])
        if layer % 2 == 0:
            e = layer // 2
            m = even_mixer(h, ev_w_in[e], ev_b_f[e], ev_pool_w[e], ev_pool_scale[e], ev_w_out[e])
        else:
            o = layer // 2
            m = odd_mixer(h, od_w_in[o], od_conv_w[o], od_conv_b[o], od_w_a[o], od_b_a[o],
                          od_w_x[o], od_b_x[o], od_lam[o], od_w_out[o])
        x = x + rmsnorm(m, mix_post_g[layer])
        h = rmsnorm(x, ffn_pre_g[layer])
        x = x + rmsnorm(swiglu(h, ffn_w_gate[layer], ffn_w_up[layer], ffn_w_down[layer]), ffn_post_g[layer])
    return x
```

```cpp
#include <hip/hip_runtime.h>
#include <hip/hip_cooperative_groups.h>
#include <cstdio>
#include <cstdint>
#include <cmath>
namespace cg = cooperative_groups;
namespace pg8 {
#define PG8_LAS __attribute__((address_space(3)))
typedef unsigned short bf16_t;
typedef short bf16x8 __attribute__((ext_vector_type(8)));
typedef float f32x4 __attribute__((ext_vector_type(4)));
typedef unsigned u32x4 __attribute__((ext_vector_type(4)));
constexpr int BM = 256, BK = 64, HALF = 128, HTB = HALF * BK * 2  , STAGE_BYTES = 8 * HTB, NXCD = 8, WGM = 8;

__host__ __device__ __forceinline__ int lds_byte(int r, int c) { const int st = (r >> 4) * 2 + (c >> 5), rr = r & 15, cc = c & 31, ob = rr * 64 + cc * 2; return st * 1024 + (ob ^ (((ob >> 9) & 1) << 5)); }
__host__ __device__ __forceinline__ void stage_rc(int b, int& R, int& C) { const int st = b / 1024, sb = b % 1024, swz = sb ^ (((sb >> 9) & 1) << 5); R = (st >> 1) * 16 + swz / 64; C = (st & 1) * 32 + (swz % 64) / 2; }
__host__ __device__ __forceinline__ int perm32(int rho) { const int n = rho >> 4, i = rho & 15; return 8 * (i >> 2) + 4 * n + (i & 3); }

struct Unit { int pm, pn; };
struct Gemm { const bf16_t* A; const bf16_t* Bt; int M, N, K; };

struct StaticOrder {
    int nM, nN, nwg, G, c;
    __host__ __device__ void init(int M, int N, int G_, int c_) { nM = M / BM; nN = N / BM; nwg = nM * nN; G = G_; c = c_; }
    __host__ __device__ bool next(int i, Unit& u) const {
        const long L = (long)i * G + c; if (L >= nwg) return false;
        int wgid = (int)L; { const int q = nwg / NXCD, r = nwg % NXCD, xcd = wgid % NXCD, off = wgid / NXCD; wgid = (xcd < r ? xcd * (q + 1) : r * (q + 1) + (xcd - r) * q) + off; }
        const int nig = WGM * nN, gid = wgid / nig, fm = gid * WGM, gsz = (nM - fm) < WGM ? (nM - fm) : WGM;
        u.pm = fm + ((wgid % nig) % gsz); u.pn = (wgid % nig) / gsz; return true;
    }
    __device__ __forceinline__ void a_ready(const Unit&) const {}
    __device__ __forceinline__ void done(const Unit&) const {}
};

__device__ __forceinline__ unsigned cvt_pk_bf16(float lo, float hi) { unsigned r; asm volatile("v_cvt_pk_bf16_f32 %0, %1, %2" : "=v"(r) : "v"(lo), "v"(hi)); return r; }
typedef float f32x2 __attribute__((ext_vector_type(2)));
template <class Epi, class Sched, bool ALIGN_EPI = false, bool SP2 = false>
__device__ __forceinline__ void gemm_phase(PG8_LAS unsigned char* lds, const Gemm g, const Sched& S, const Epi& E, int tid_in) {
    int tid_ = tid_in; asm volatile("" : "+v"(tid_)); const int tid = tid_, wid = __builtin_amdgcn_readfirstlane(tid >> 6), lane = tid & 63, wr = wid >> 2, wc = wid & 3, fr = lane & 15, fq = lane >> 4;
    const int K = g.K, nt = K / BK;
    unsigned voffA[2], voffB[2];
#pragma unroll
    for (int i = 0; i < 2; ++i) { int R, C; stage_rc(tid * 16 + i * 8192, R, C); const int Rb = Epi::PERM ? ((R & ~31) + perm32(R & 31)) : R;
        voffA[i] = (unsigned)(R * K + C) * 2u; voffB[i] = (unsigned)(Rb * K + C) * 2u; }
    const size_t kstep = (size_t)(BK * 2);
    const size_t hstep = (size_t)HALF * K * 2;
    const size_t tstep = 2 * hstep;
    const unsigned ldsw = (unsigned)wid * 1024u;
    const int aoff = lds_byte(wr * 64 + fr, fq * 8), boff = lds_byte(wc * 32 + fr, fq * 8);
#define PG8_SA(b, h) (((b) * 2 + (h)) * HTB)
#define PG8_SB(b, h) ((4 + (b) * 2 + (h)) * HTB)
#define PG8_STAGE(bufoff, gbase, voff) do { _Pragma("unroll") for (int _i = 0; _i < 2; ++_i) \
        __builtin_amdgcn_global_load_lds((const unsigned*)((const char*)(gbase) + (voff)[_i]), (PG8_LAS unsigned*)(lds + (bufoff) + ldsw + _i * 8192), 16, 0, 0); } while (0)
#define PG8_LDA(dst, b, h) do { _Pragma("unroll") for (int m = 0; m < 4; ++m) _Pragma("unroll") for (int k = 0; k < 2; ++k) dst[m][k] = *(const PG8_LAS bf16x8*)(lds + PG8_SA(b, h) + aoff + m * 2048 + k * 1024); } while (0)
#define PG8_LDB(dst, b, h) do { _Pragma("unroll") for (int n = 0; n < 2; ++n) _Pragma("unroll") for (int k = 0; k < 2; ++k) dst[n][k] = *(const PG8_LAS bf16x8*)(lds + PG8_SB(b, h) + boff + n * 2048 + k * 1024); } while (0)
#define PG8_MMA(ai, bj, At, Bt) do { __builtin_amdgcn_s_setprio(1); _Pragma("unroll") for (int m = 0; m < 4; ++m) _Pragma("unroll") for (int n = 0; n < 2; ++n) _Pragma("unroll") for (int k = 0; k < 2; ++k) \
        acc[ai][bj][m][n] = __builtin_amdgcn_mfma_f32_16x16x32_bf16(Bt[n][k], At[m][k], acc[ai][bj][m][n], 0, 0, 0); __builtin_amdgcn_s_setprio(0); } while (0)
#define PG8_WAIT_V(n) asm volatile("s_waitcnt vmcnt(" #n ")" ::: "memory")
#define PG8_WAIT_L(n) asm volatile("s_waitcnt lgkmcnt(" #n ")" ::: "memory")
#define PG8_BAR __builtin_amdgcn_s_barrier()
#define PG8_SCHED __builtin_amdgcn_sched_barrier(0)
    Unit cur, nxt; int ui = 0;
    if (!S.next(0, cur)) return;
    f32x4 acc[2][2][4][2];
#pragma unroll
    for (int a = 0; a < 2; ++a)
#pragma unroll
        for (int b = 0; b < 2; ++b)
#pragma unroll
            for (int m = 0; m < 4; ++m)
#pragma unroll
                for (int n = 0; n < 2; ++n) acc[a][b][m][n] = (f32x4){0.f, 0.f, 0.f, 0.f};
    bf16x8 At[4][2], B0[2][2], B1[2][2];
    const char* cA = (const char*)g.A + (size_t)cur.pm * tstep; const char* cB = (const char*)g.Bt + (size_t)cur.pn * tstep;
    S.a_ready(cur);
    if constexpr (SP2) {
        PG8_STAGE(PG8_SB(0, 0), cB, voffB); PG8_STAGE(PG8_SB(0, 1), cB + hstep, voffB); PG8_STAGE(PG8_SA(0, 0), cA, voffA); PG8_STAGE(PG8_SA(0, 1), cA + hstep, voffA);
        if (wr == 1) PG8_BAR;
        PG8_WAIT_V(2); PG8_BAR;
        PG8_STAGE(PG8_SB(1, 0), cB + kstep, voffB); PG8_STAGE(PG8_SA(1, 0), cA + kstep, voffA); PG8_STAGE(PG8_SB(1, 1), cB + hstep + kstep, voffB);
        PG8_WAIT_V(6); PG8_BAR;
    } else {
        PG8_STAGE(PG8_SB(0, 0), cB, voffB); PG8_STAGE(PG8_SA(0, 0), cA, voffA); PG8_STAGE(PG8_SB(0, 1), cB + hstep, voffB); PG8_STAGE(PG8_SA(0, 1), cA + hstep, voffA);
        if (wr == 1) PG8_BAR;
        PG8_WAIT_V(4); PG8_BAR;
        PG8_STAGE(PG8_SB(1, 0), cB + kstep, voffB); PG8_STAGE(PG8_SA(1, 0), cA + kstep, voffA); PG8_STAGE(PG8_SB(1, 1), cB + hstep + kstep, voffB);
        PG8_WAIT_V(6); PG8_BAR;
    }
    for (;;) {
        const bool has_next = S.next(ui + 1, nxt);
        const char* nA = has_next ? (const char*)g.A + (size_t)nxt.pm * tstep : cA; const char* nB = has_next ? (const char*)g.Bt + (size_t)nxt.pn * tstep : cB;
        for (int t = 0; t < nt; t += 2) {
            const bool last = (t == nt - 2);
            const char* a1 = cA + (size_t)(t + 1) * kstep;
            const char* a2 = last ? nA : cA + (size_t)(t + 2) * kstep; const char* b2 = last ? nB : cB + (size_t)(t + 2) * kstep;
            const char* a3 = a2 + kstep; const char* b3 = b2 + kstep;
            if (last && has_next) S.a_ready(nxt);
            if constexpr (SP2) {
            PG8_LDB(B0, 0, 0); PG8_LDB(B1, 0, 1); PG8_SCHED; PG8_LDA(At, 0, 0); PG8_STAGE(PG8_SA(1, 1), a1 + hstep, voffA);
            PG8_WAIT_V(8); PG8_WAIT_L(0); PG8_BAR; PG8_MMA(0, 0, At, B0); PG8_MMA(0, 1, At, B1); PG8_BAR; PG8_SCHED;
            PG8_LDA(At, 0, 1); PG8_STAGE(PG8_SB(0, 0), b2, voffB); PG8_STAGE(PG8_SB(0, 1), b2 + hstep, voffB); PG8_STAGE(PG8_SA(0, 0), a2, voffA);
            PG8_WAIT_V(8); PG8_WAIT_L(0); PG8_BAR; PG8_MMA(1, 0, At, B0); PG8_MMA(1, 1, At, B1); PG8_BAR; PG8_SCHED;
            PG8_LDB(B0, 1, 0); PG8_LDB(B1, 1, 1); PG8_SCHED; PG8_LDA(At, 1, 0); PG8_STAGE(PG8_SA(0, 1), a2 + hstep, voffA);
            PG8_WAIT_V(8); PG8_WAIT_L(0); PG8_BAR; PG8_MMA(0, 0, At, B0); PG8_MMA(0, 1, At, B1); PG8_BAR; PG8_SCHED;
            PG8_LDA(At, 1, 1); PG8_STAGE(PG8_SB(1, 0), b3, voffB); PG8_STAGE(PG8_SB(1, 1), b3 + hstep, voffB); PG8_STAGE(PG8_SA(1, 0), a3, voffA);
            PG8_WAIT_V(8); PG8_WAIT_L(0); PG8_BAR; PG8_MMA(1, 0, At, B0); PG8_MMA(1, 1, At, B1); PG8_BAR; PG8_SCHED;
            } else {
            PG8_LDB(B0, 0, 0); PG8_SCHED; PG8_LDA(At, 0, 0); PG8_STAGE(PG8_SA(1, 1), a1 + hstep, voffA);
            PG8_WAIT_L(8); PG8_BAR; PG8_WAIT_L(0); PG8_MMA(0, 0, At, B0); PG8_BAR; PG8_SCHED;
            PG8_LDB(B1, 0, 1); PG8_STAGE(PG8_SB(0, 0), b2, voffB);
            PG8_BAR; PG8_WAIT_L(0); PG8_MMA(0, 1, At, B1); PG8_BAR;
            PG8_LDA(At, 0, 1); PG8_STAGE(PG8_SA(0, 0), a2, voffA);
            PG8_BAR; PG8_WAIT_L(0); PG8_MMA(1, 0, At, B0); PG8_BAR; PG8_SCHED;
            PG8_STAGE(PG8_SB(0, 1), b2 + hstep, voffB);
            PG8_WAIT_V(6); PG8_BAR; PG8_MMA(1, 1, At, B1); PG8_BAR;
            PG8_LDB(B0, 1, 0); PG8_SCHED; PG8_LDA(At, 1, 0); PG8_STAGE(PG8_SA(0, 1), a2 + hstep, voffA);
            PG8_WAIT_L(8); PG8_BAR; PG8_WAIT_L(0); PG8_MMA(0, 0, At, B0); PG8_BAR; PG8_SCHED;
            PG8_LDB(B1, 1, 1); PG8_STAGE(PG8_SB(1, 0), b3, voffB);
            PG8_BAR; PG8_WAIT_L(0); PG8_MMA(0, 1, At, B1); PG8_BAR;
            PG8_LDA(At, 1, 1); PG8_STAGE(PG8_SA(1, 0), a3, voffA);
            PG8_BAR; PG8_WAIT_L(0); PG8_MMA(1, 0, At, B0); PG8_BAR; PG8_SCHED;
            PG8_STAGE(PG8_SB(1, 1), b3 + hstep, voffB);
            PG8_WAIT_V(6); PG8_BAR; PG8_MMA(1, 1, At, B1); PG8_BAR;
            }
        }
        if constexpr (ALIGN_EPI) { if (wr == 0) PG8_BAR; }
        if constexpr (!Epi::AFTER_DRAIN) { E(acc, cur, wr, wc, fr, fq); S.done(cur); }
        if (!has_next) break;
#pragma unroll
        for (int a = 0; a < 2; ++a)
#pragma unroll
            for (int b = 0; b < 2; ++b)
#pragma unroll
                for (int m = 0; m < 4; ++m)
#pragma unroll
                    for (int n = 0; n < 2; ++n) acc[a][b][m][n] = (f32x4){0.f, 0.f, 0.f, 0.f};
        cur = nxt; cA = nA; cB = nB; ++ui;
        if constexpr (ALIGN_EPI) { if (wr == 1) PG8_BAR; }
    }
    PG8_WAIT_V(0);
    if constexpr (!ALIGN_EPI) { if (wr == 0) PG8_BAR; }
    PG8_BAR;
    if constexpr (Epi::AFTER_DRAIN) { E.fused(acc, cur, wr, wc, fr, fq, lds, wid, lane); S.done(cur); }
#undef PG8_SA
#undef PG8_SB
#undef PG8_STAGE
#undef PG8_LDA
#undef PG8_LDB
#undef PG8_MMA
#undef PG8_WAIT_V
#undef PG8_WAIT_L
#undef PG8_BAR
#undef PG8_SCHED
}
}
#ifndef PROBE_DUP_EPI
#define PROBE_DUP_EPI 0
#endif
#ifndef PROBE_EW
#define PROBE_EW 0
#endif
#ifndef PROBE_DUP_MASK
#define PROBE_DUP_MASK 0
#endif
#ifndef PROBE_DUP_BAR
#define PROBE_DUP_BAR 0
#endif
#ifndef MK_PER_PHASE
#define MK_PER_PHASE 0
#endif
using pg8::bf16_t; using pg8::bf16x8; using pg8::f32x4; using pg8::u32x4; using pg8::Unit;
typedef float f32x16 __attribute__((ext_vector_type(16)));
typedef float f32x2 __attribute__((ext_vector_type(2)));
typedef unsigned u32x2 __attribute__((ext_vector_type(2)));
#define LAS __attribute__((address_space(3)))

constexpr int BATCH = 4, SEQ = 8192, DM = 1024, T = BATCH * SEQ;
constexpr int NHEAD = 8, HD = 64, EV_IN = 2056, DFF = 2816;
constexpr float RMS_EPS = 1e-6f;
constexpr float LOG2E = 1.4426950408889634f;
constexpr float QSCALE = 0.125f * LOG2E;
constexpr int NPHASE = 18;
constexpr int LDS_BYTES = 163840;
constexpr int LDS_RS_OFF = 131072 + 2048;

constexpr size_t MiB = 1u << 20;
constexpr size_t WS_WIN0 = 0, WS_WOUT0 = 4 * MiB, WS_WGU0 = 6 * MiB, WS_WD0 = 17 * MiB, WS_WIN1 = 23 * MiB, WS_WAX = 27 * MiB, WS_WOUT1 = 28 * MiB,
                 WS_WGU1 = 30 * MiB, WS_WD1 = 41 * MiB, WS_LOGF = 47 * MiB, WS_C2 = 48 * MiB, WS_LU = 49 * MiB, WS_SP = 50 * MiB, WS_SH = 51 * MiB, WS_BAR = 52 * MiB, WS_KC = 53 * MiB, WS_CTL2 = 55 * MiB, WS_RS = 55 * MiB + 512 * 1024;
constexpr size_t WS_XN = 56 * MiB, WS_M = 120 * MiB, WS_S = 184 * MiB;
constexpr size_t WS_QKVU = WS_S, WS_CAT = WS_S + 128 * MiB, WS_H = WS_S;
constexpr size_t WS_G = WS_S, WS_XC = WS_S + 64 * MiB, WS_BV = WS_S + 128 * MiB, WS_XR = WS_S + 192 * MiB, WS_A32 = WS_S + 192 * MiB, WS_YG = WS_XC;
constexpr size_t WS_END = WS_S + 320 * MiB;

__device__ __forceinline__ unsigned pk2(float lo, float hi) { return pg8::cvt_pk_bf16(lo, hi); }
__device__ __forceinline__ float bf_lo(unsigned w) { return __uint_as_float(w << 16); }
__device__ __forceinline__ float bf_hi(unsigned w) { return __uint_as_float(w & 0xffff0000u); }
__device__ __forceinline__ float wave_sum(float v) {
#define WS_DPP(x, ctrl, rmask) __builtin_bit_cast(float, __builtin_amdgcn_update_dpp(0, __builtin_bit_cast(int, (x)), (ctrl), (rmask), 0xF, false))
    v += WS_DPP(v, 0x111, 0xF);
    v += WS_DPP(v, 0x112, 0xF);
    v += WS_DPP(v, 0x114, 0xF);
    v += WS_DPP(v, 0x118, 0xF);
    v += WS_DPP(v, 0x142, 0xA);
    v += WS_DPP(v, 0x143, 0xC);
#undef WS_DPP
    return __builtin_bit_cast(float, __builtin_amdgcn_readlane(__builtin_bit_cast(int, v), 63));
}
__device__ __forceinline__ float fast_sigmoid(float x) { return __builtin_amdgcn_rcpf(1.f + __expf(-x)); }
__device__ __forceinline__ float softplus_f(float z) { return fmaxf(z, 0.f) + log1pf(__expf(-fabsf(z))); }
__device__ __forceinline__ float gelu_tanh(float x) { const float u = 0.7978845608028654f * (x + 0.044715f * x * x * x); return x * fast_sigmoid(2.f * u); }

struct Args { const float* in[22]; float* out; unsigned char* ws; int ph_lo, ph_hi; };
enum { I_X = 0, I_MIX_PRE, I_MIX_POST, I_FFN_PRE, I_FFN_POST, I_WGATE, I_WUP, I_WDOWN, I_EV_WIN, I_EV_BF, I_EV_POOLW, I_EV_POOLS, I_EV_WOUT,
       I_OD_WIN, I_OD_CONVW, I_OD_CONVB, I_OD_WA, I_OD_BA, I_OD_WX, I_OD_BX, I_OD_LAM, I_OD_WOUT };

template <bool RSL> struct RowScale {
    const float* RS; const LAS float* rsl; int rbase;
    __device__ __forceinline__ float operator()(int row) const { if (RSL) return rsl[row - rbase]; else return RS[row]; }
};
template <bool RSL> struct EpiQKVU {
    static constexpr bool PERM = true, AFTER_DRAIN = false;
    bf16_t* O; unsigned* kmax; RowScale<RSL> RS;
    __device__ __forceinline__ void operator()(const f32x4 (&acc)[2][2][4][2], const Unit& u, int wr, int wc, int fr, int fq) const {
        const int seg = u.pn >> 1; const float sc0 = seg == 0 ? QSCALE : 1.f;
        bf16_t* base = O + (size_t)seg * T * 512 + (u.pn & 1) * 256 + wc * 32 + 8 * fq;
        const int row0 = u.pm * 256 + wr * 64 + fr;
#pragma unroll
        for (int ai = 0; ai < 2; ++ai)
#pragma unroll
            for (int m = 0; m < 4; ++m) { bf16_t* rowp = base + (size_t)(row0 + ai * 128 + m * 16) * 512; const float sc = sc0 * RS(row0 + ai * 128 + m * 16);
#pragma unroll
                for (int bj = 0; bj < 2; ++bj) { const f32x4 v0 = acc[ai][bj][m][0] * sc, v1 = acc[ai][bj][m][1] * sc;
                    u32x4 w; w.x = pk2(v0[0], v0[1]); w.y = pk2(v0[2], v0[3]); w.z = pk2(v1[0], v1[1]); w.w = pk2(v1[2], v1[3]);
                    *(u32x4*)(rowp + bj * 128) = w; } }
        if (seg == 1) {
            float mx[2] = {0.f, 0.f};
#pragma unroll
            for (int bj = 0; bj < 2; ++bj)
#pragma unroll
                for (int ai = 0; ai < 2; ++ai)
#pragma unroll
                    for (int mm = 0; mm < 4; ++mm) { const float rs = RS(row0 + ai * 128 + mm * 16); float s = 0.f;
#pragma unroll
                        for (int n = 0; n < 2; ++n)
#pragma unroll
                            for (int i = 0; i < 4; ++i) { const float v = acc[ai][bj][mm][n][i] * rs; s += v * v; }
                        s += __shfl_xor(s, 16); s += __shfl_xor(s, 32);
                        mx[bj] = fmaxf(mx[bj], s); }
#pragma unroll
            for (int o = 1; o < 16; o <<= 1) { mx[0] = fmaxf(mx[0], __shfl_xor(mx[0], o)); mx[1] = fmaxf(mx[1], __shfl_xor(mx[1], o)); }
            if (fr == 0 && fq == 0) { unsigned* kp = kmax + (u.pm >> 5) * 8 + (u.pn & 1) * 4 + (wc >> 1);
                atomicMax(kp, __float_as_uint(mx[0])); atomicMax(kp + 2, __float_as_uint(mx[1])); }
        }
    }
};
struct EpiPlain {
    static constexpr bool PERM = true, AFTER_DRAIN = false;
    bf16_t* O; int ldc;
    __device__ __forceinline__ void operator()(const f32x4 (&acc)[2][2][4][2], const Unit& u, int wr, int wc, int fr, int fq) const {
        bf16_t* base = O + u.pn * 256 + wc * 32 + 8 * fq; const int row0 = u.pm * 256 + wr * 64 + fr;
#pragma unroll
        for (int ai = 0; ai < 2; ++ai)
#pragma unroll
            for (int m = 0; m < 4; ++m) { bf16_t* rowp = base + (size_t)(row0 + ai * 128 + m * 16) * ldc;
#pragma unroll
                for (int bj = 0; bj < 2; ++bj) { const f32x4 v0 = acc[ai][bj][m][0], v1 = acc[ai][bj][m][1];
                    u32x4 w; w.x = pk2(v0[0], v0[1]); w.y = pk2(v0[2], v0[3]); w.z = pk2(v1[0], v1[1]); w.w = pk2(v1[2], v1[3]);
                    *(u32x4*)(rowp + bj * 128) = w; } }
    }
};
template <bool RSL> struct EpiSwiglu {
    static constexpr bool PERM = true, AFTER_DRAIN = false;
    bf16_t* H; RowScale<RSL> RS;
    __device__ __forceinline__ void operator()(const f32x4 (&acc)[2][2][4][2], const Unit& u, int wr, int wc, int fr, int fq) const {
        bf16_t* base = H + u.pn * 128 + wc * 32 + 8 * fq; const int row0 = u.pm * 256 + wr * 64 + fr;
        for (int rep_e = 0; rep_e <= PROBE_DUP_EPI; ++rep_e) { asm volatile("" ::: "memory");
#pragma unroll
        for (int ai = 0; ai < 2; ++ai)
#pragma unroll
            for (int m = 0; m < 4; ++m) { bf16_t* rowp = base + (size_t)(row0 + ai * 128 + m * 16) * DFF; const float rs = RS(row0 + ai * 128 + m * 16);
                float o[8];
#pragma unroll
                for (int n = 0; n < 2; ++n)
#pragma unroll
                    for (int i = 0; i < 4; ++i) { const float g = acc[ai][0][m][n][i] * rs, up = acc[ai][1][m][n][i] * rs; o[n * 4 + i] = g * fast_sigmoid(g) * up; }
                u32x4 w; w.x = pk2(o[0], o[1]); w.y = pk2(o[2], o[3]); w.z = pk2(o[4], o[5]); w.w = pk2(o[6], o[7]);
                *(u32x4*)rowp = w; }
        }
    }
};
template <bool RSL> struct EpiOddIn {
    static constexpr bool PERM = true, AFTER_DRAIN = false;
    bf16_t* G; bf16_t* XR; RowScale<RSL> RS;
    __device__ __forceinline__ void operator()(const f32x4 (&acc)[2][2][4][2], const Unit& u, int wr, int wc, int fr, int fq) const {
        const bool isg = u.pn < 4;
        bf16_t* base = (isg ? G : XR) + (u.pn & 3) * 256 + wc * 32 + 8 * fq; const int row0 = u.pm * 256 + wr * 64 + fr;
#pragma unroll
        for (int ai = 0; ai < 2; ++ai)
#pragma unroll
            for (int m = 0; m < 4; ++m) { bf16_t* rowp = base + (size_t)(row0 + ai * 128 + m * 16) * 1024; const float rs = RS(row0 + ai * 128 + m * 16);
#pragma unroll
                for (int bj = 0; bj < 2; ++bj) { f32x4 v0 = acc[ai][bj][m][0] * rs, v1 = acc[ai][bj][m][1] * rs;
                    if (isg) {
#pragma unroll
                        for (int i = 0; i < 4; ++i) { v0[i] = gelu_tanh(v0[i]); v1[i] = gelu_tanh(v1[i]); } }
                    u32x4 w; w.x = pk2(v0[0], v0[1]); w.y = pk2(v0[2], v0[3]); w.z = pk2(v1[0], v1[1]); w.w = pk2(v1[2], v1[3]);
                    *(u32x4*)(rowp + bj * 128) = w; } }
    }
};
struct EpiGates {
    static constexpr bool PERM = true, AFTER_DRAIN = false;
    const bf16_t* XC; const float* b_a; const float* b_x; const float* LU; bf16_t* LA; bf16_t* BV;
    __device__ __forceinline__ void operator()(const f32x4 (&acc)[2][2][4][2], const Unit& u, int wr, int wc, int fr, int fq) const {
        asm volatile("" : "+v"(fr), "+v"(fq));
        const int h = u.pm >> 7, j = u.pn & 1, cl = j * 128 + wc * 32 + 8 * fq, c = h * 256 + cl;
        const int t0 = (u.pm & 127) * 256 + wr * 64 + fr;
        f32x4 ba[2], bx[2], lu[2]; u32x4 xw[2][4];
#pragma unroll
        for (int n = 0; n < 2; ++n) { ba[n] = *(const f32x4*)(b_a + c + 4 * n); bx[n] = *(const f32x4*)(b_x + c + 4 * n); lu[n] = *(const f32x4*)(LU + c + 4 * n); }
#pragma unroll
        for (int ai = 0; ai < 2; ++ai)
#pragma unroll
            for (int m = 0; m < 4; ++m) xw[ai][m] = *(const u32x4*)(XC + ((size_t)h * T + t0 + ai * 128 + m * 16) * 256 + cl);
#pragma unroll
        for (int ai = 0; ai < 2; ++ai)
#pragma unroll
            for (int m = 0; m < 4; ++m) { const int t = t0 + ai * 128 + m * 16; const u32x4 x = xw[ai][m];
                const float xc[8] = {bf_lo(x.x), bf_hi(x.x), bf_lo(x.y), bf_hi(x.y), bf_lo(x.z), bf_hi(x.z), bf_lo(x.w), bf_hi(x.w)};
                float lv[8], x2v[8], gx[8], bv[8];
#pragma unroll
                for (int i = 0; i < 8; ++i) { const int n = i >> 2, e = i & 3; const float rp = acc[ai][0][m][n][e] + ba[n][e], ip = acc[ai][1][m][n][e] + bx[n][e];
                    const float r = fast_sigmoid(rp), ig = fast_sigmoid(ip); const float la = r * lu[n][e];
                    lv[i] = la * LOG2E; x2v[i] = 2.f * la; gx[i] = ig * xc[i]; }
                bool bigl = false;
#pragma unroll
                for (int i = 0; i < 8; ++i) bigl |= (x2v[i] <= -0.25f);
                const bool big = __any(bigl);
#pragma unroll
                for (int i = 0; i < 8; ++i) { const float x2 = x2v[i];
                    float om = -x2 * (1.f + x2 * (0.5f + x2 * (0.16666667f + x2 * (0.041666668f + x2 * (0.008333334f + x2 * 0.0013888889f)))));
                    if (big) { const float dr = 1.f - __expf(x2); om = x2 > -0.25f ? om : dr; }
                    bv[i] = __builtin_amdgcn_sqrtf(fmaxf(om, 0.f)) * gx[i]; }
                u32x4 lw; lw.x = pk2(lv[0], lv[1]); lw.y = pk2(lv[2], lv[3]); lw.z = pk2(lv[4], lv[5]); lw.w = pk2(lv[6], lv[7]);
                u32x4 w; w.x = pk2(bv[0], bv[1]); w.y = pk2(bv[2], bv[3]); w.z = pk2(bv[4], bv[5]); w.w = pk2(bv[6], bv[7]);
                *(u32x4*)(LA + (size_t)t * 1024 + c) = lw; *(u32x4*)(BV + (size_t)t * 1024 + c) = w; }
    }
};
struct GatesOrder {
    int G, c;
    __device__ bool next(int i, Unit& u) const { const long L = (long)i * G + c; if (L >= 1024) return false; const int l = (int)L; u.pm = l >> 1; u.pn = 2 * (u.pm >> 7) + (l & 1); return true; }
    __device__ __forceinline__ void a_ready(const Unit&) const {}
    __device__ __forceinline__ void done(const Unit&) const {}
};
__device__ __forceinline__ void tr_item(const float* __restrict__ W, int ld, int k0, int c0, bf16_t* __restrict__ WT, int Kd, int drow0, LAS float* scr, int lane, const float* __restrict__ gk = nullptr) {
    const int r8 = lane >> 3, ch = lane & 7;
    f32x4 v[8];
#pragma unroll
    for (int i = 0; i < 8; ++i) v[i] = *(const f32x4*)(W + (size_t)(k0 + r8 + 8 * i) * ld + c0 + 4 * ch);
    if (gk) {
#pragma unroll
        for (int i = 0; i < 8; ++i) v[i] = v[i] * gk[k0 + r8 + 8 * i]; }
#pragma unroll
    for (int i = 0; i < 8; ++i) { LAS float* d = scr + (r8 + 8 * i) * 33 + 4 * ch; d[0] = v[i][0]; d[1] = v[i][1]; d[2] = v[i][2]; d[3] = v[i][3]; }
    asm volatile("s_waitcnt lgkmcnt(0)" ::: "memory");
    const int c = lane & 7;
#pragma unroll
    for (int j = 0; j < 4; ++j) { const int n = (lane >> 3) + 8 * j; const LAS float* s = scr + (8 * c) * 33 + n;
        u32x4 o; o.x = pk2(s[0 * 33], s[1 * 33]); o.y = pk2(s[2 * 33], s[3 * 33]); o.z = pk2(s[4 * 33], s[5 * 33]); o.w = pk2(s[6 * 33], s[7 * 33]);
        *(u32x4*)(WT + (size_t)(drow0 + n) * Kd + k0 + 8 * c) = o; }
    asm volatile("s_waitcnt lgkmcnt(0)" ::: "memory");
}
__device__ __forceinline__ void phase0(const Args& a, unsigned char* lds, int tid, int lane, int wave) {
    unsigned char* ws = a.ws;
    LAS float* scr = (LAS float*)lds + wave * 4096;
    const int gw = blockIdx.x * 8 + wave, NGW = gridDim.x * 8;
    constexpr int NITEMS = 768 + 512 + 5632 + 2816 + 1024 + 256 + 512;
    for (int it = gw; it < NITEMS; it += NGW) {
        int r = it;
        if (r < 768) { const int kb = r / 48, nb = r % 48; tr_item(a.in[I_EV_WIN], EV_IN, 64 * kb, 32 * nb, (bf16_t*)(ws + WS_WIN0), 1024, 32 * nb, scr, lane, a.in[I_MIX_PRE]); continue; } r -= 768;
        if (r < 512) { const int kb = r / 32, nb = r % 32; tr_item(a.in[I_EV_WOUT], 1024, 64 * kb, 32 * nb, (bf16_t*)(ws + WS_WOUT0), 1024, 32 * nb, scr, lane); continue; } r -= 512;
        if (r < 5632) { const int which = r / 1408; r %= 1408; const int l = which >> 1, up = which & 1, kb = r / 88, nb = r % 88, c0 = 32 * nb;
            const float* src = (up ? a.in[I_WUP] : a.in[I_WGATE]) + (size_t)l * 1024 * DFF; bf16_t* dst = (bf16_t*)(ws + (l ? WS_WGU1 : WS_WGU0));
            tr_item(src, DFF, 64 * kb, c0, dst, 1024, 256 * (c0 >> 7) + 128 * up + (c0 & 127), scr, lane, a.in[I_FFN_PRE] + l * 1024); continue; } r -= 5632;
        if (r < 2816) { const int l = r / 1408; r %= 1408; const int kb = r / 32, nb = r % 32;
            tr_item(a.in[I_WDOWN] + (size_t)l * DFF * 1024, 1024, 64 * kb, 32 * nb, (bf16_t*)(ws + (l ? WS_WD1 : WS_WD0)), DFF, 32 * nb, scr, lane); continue; } r -= 2816;
        if (r < 1024) { const int kb = r / 64, nb = r % 64; tr_item(a.in[I_OD_WIN], 2048, 64 * kb, 32 * nb, (bf16_t*)(ws + WS_WIN1), 1024, 32 * nb, scr, lane, a.in[I_MIX_PRE] + 1024); continue; } r -= 1024;
        if (r < 256) { const int which = r / 128; r %= 128; const int h = r / 32; r %= 32; const int kb = r / 8, nb = r % 8, c0 = 32 * nb;
            const float* src = (which ? a.in[I_OD_WX] : a.in[I_OD_WA]) + (size_t)h * 65536;
            tr_item(src, 256, 64 * kb, c0, (bf16_t*)(ws + WS_WAX), 256, 512 * h + 256 * (c0 >> 7) + 128 * which + (c0 & 127), scr, lane); continue; } r -= 256;
        { const int kb = r / 32, nb = r % 32; tr_item(a.in[I_OD_WOUT], 1024, 64 * kb, 32 * nb, (bf16_t*)(ws + WS_WOUT1), 1024, 32 * nb, scr, lane); }
    }
    for (int u = blockIdx.x; u < 256; u += gridDim.x) {
        const int g = u >> 6, k0 = (u & 63) * 16;
        float* As = (float*)lds; float* Wp = As + 16 * 128;
        __syncthreads();
        { const int row = tid >> 5, c4 = tid & 31; ((f32x4*)As)[tid] = *(const f32x4*)(a.in[I_EV_WIN] + (size_t)(k0 + row) * EV_IN + 1544 + g * 128 + c4 * 4); }
        for (int i = tid; i < 128 * 32; i += 512) ((f32x4*)Wp)[i] = *(const f32x4*)(a.in[I_EV_POOLW] + (size_t)g * 16384 + i * 4);
        __syncthreads();
        const int e = tid & 127, kq = tid >> 7;
        float acc[4] = {0.f, 0.f, 0.f, 0.f};
        for (int d = 0; d < 128; d += 4) {
            const float w0 = Wp[(d + 0) * 128 + e], w1 = Wp[(d + 1) * 128 + e], w2 = Wp[(d + 2) * 128 + e], w3 = Wp[(d + 3) * 128 + e];
#pragma unroll
            for (int i = 0; i < 4; ++i) { const f32x4 av = *(const f32x4*)(As + (kq * 4 + i) * 128 + d); acc[i] += av[0] * w0 + av[1] * w1 + av[2] * w2 + av[3] * w3; }
        }
        const float sc = a.in[I_EV_POOLS][g * 128 + e];
#pragma unroll
        for (int i = 0; i < 4; ++i) acc[i] *= sc * a.in[I_MIX_PRE][k0 + kq * 4 + i];
        u32x2 w; w.x = pk2(acc[0], acc[1]); w.y = pk2(acc[2], acc[3]);
        *(u32x2*)((bf16_t*)(ws + WS_WIN0) + (size_t)(1536 + g * 128 + e) * 1024 + k0 + kq * 4) = w;
    }
    if (blockIdx.x == gridDim.x - 1) for (int c = tid; c < 1024; c += 512) ((float*)(ws + WS_LU))[c] = -8.f * softplus_f(-a.in[I_OD_LAM][c]);
    __syncthreads();
    float* wf = (float*)lds;
    for (int i = tid; i < 8192; i += 512) { const int hd = i & 7, k = i >> 3; wf[hd * 1024 + k] = a.in[I_EV_WIN][(size_t)k * EV_IN + 1536 + hd]; }
    __syncthreads();
    f32x4 g4[4];
#pragma unroll
    for (int j = 0; j < 4; ++j) g4[j] = *(const f32x4*)(a.in[I_MIX_PRE] + 256 * j + 4 * lane);
    const float bfl = a.in[I_EV_BF][lane & 7];
    bf16_t* XN = (bf16_t*)(ws + WS_XN); float* LOGF = (float*)(ws + WS_LOGF);
    f32x4 vn[4];
    if (gw < T) {
#pragma unroll
        for (int j = 0; j < 4; ++j) vn[j] = *(const f32x4*)(a.in[I_X] + (size_t)gw * 1024 + 4 * lane + 256 * j); }
    for (int row = gw; row < T; row += NGW) {
        f32x4 v[4]; float ss = 0.f;
#pragma unroll
        for (int j = 0; j < 4; ++j) { v[j] = vn[j]; ss += (v[j][0] * v[j][0] + v[j][1] * v[j][1]) + (v[j][2] * v[j][2] + v[j][3] * v[j][3]); }
        if (row + NGW < T) {
#pragma unroll
            for (int j = 0; j < 4; ++j) vn[j] = *(const f32x4*)(a.in[I_X] + (size_t)(row + NGW) * 1024 + 4 * lane + 256 * j); }
        const float rstd = 1.f / sqrtf(wave_sum(ss) * (1.f / 1024.f) + RMS_EPS);
        bf16_t* xo = XN + (size_t)row * 1024 + 4 * lane;
#pragma unroll
        for (int j = 0; j < 4; ++j) { u32x2 w; w.x = pk2(v[j][0], v[j][1]); w.y = pk2(v[j][2], v[j][3]); *(u32x2*)(xo + 256 * j) = w; v[j] = v[j] * rstd * g4[j]; }
        if (lane == 0) ((float*)(ws + WS_RS))[row] = rstd;
        float d[8];
#pragma unroll
        for (int hd = 0; hd < 8; ++hd) { float s = 0.f;
#pragma unroll
            for (int j = 0; j < 4; ++j) { const f32x4 w = *(const f32x4*)(wf + hd * 1024 + 256 * j + 4 * lane); s += (v[j][0] * w[0] + v[j][1] * w[1]) + (v[j][2] * w[2] + v[j][3] * w[3]); }
            d[hd] = s; }
        float e1 = 0.f;
#pragma unroll
        for (int hd = 0; hd < 8; ++hd) { const float tsum = wave_sum(d[hd]); if ((lane & 7) == hd) e1 = tsum; }
        if (lane < 8) { const float z = e1 + bfl; LOGF[(size_t)row * 8 + lane] = fminf(z, 0.f) - log1pf(__expf(-fabsf(z))); }
    }
}
__device__ __forceinline__ void cumsum_phase(const Args& a, unsigned char* lds, int tid, int lane, int wave) {
    float* sm = (float*)lds;
    const float* LOGF = (const float*)(a.ws + WS_LOGF); float* C2 = (float*)(a.ws + WS_C2);
    for (int bh = blockIdx.x; bh < 32; bh += gridDim.x) {
        const int b = bh >> 3, hd = bh & 7;
        float v[16]; float tot = 0.f;
#pragma unroll
        for (int i = 0; i < 16; ++i) { v[i] = LOGF[((size_t)b * SEQ + tid * 16 + i) * 8 + hd]; tot += v[i]; v[i] = tot; }
        float inc = tot;
#pragma unroll
        for (int o = 1; o < 64; o <<= 1) { const float t = __shfl_up(inc, o); if (lane >= o) inc += t; }
        __syncthreads();
        if (lane == 63) sm[wave] = inc;
        __syncthreads();
        float base = 0.f;
        for (int w = 0; w < wave; ++w) base += sm[w];
        const float excl = base + inc - tot;
        float* o = C2 + (size_t)bh * SEQ + tid * 16;
        u32x2* kc = (u32x2*)(a.ws + WS_KC) + (size_t)bh * SEQ + tid * 16;
#pragma unroll
        for (int i = 0; i < 16; ++i) { const float c = (excl + v[i]) * LOG2E; o[i] = c;
            const unsigned hi = pk2(c, 0.f) & 0xffffu; const float r1 = c - bf_lo(hi); const unsigned mid = pk2(r1, 0.f) & 0xffffu; const float r2 = r1 - bf_lo(mid); const unsigned lo = pk2(r2, 0.f) & 0xffffu;
            u32x2 w; w.x = hi | (mid << 16); w.y = lo; kc[i] = w; }
    }
    __syncthreads();
}
__device__ __forceinline__ void pool_phase(const Args& a, int tid) {
    const bf16_t* __restrict__ U = (const bf16_t*)(a.ws + WS_QKVU) + (size_t)3 * T * 512; bf16_t* __restrict__ CAT = (bf16_t*)(a.ws + WS_CAT);
    const int ch = tid & 63, ts = tid >> 6, g = ch >> 4, w = 2 << g;
    for (int u = blockIdx.x; u < T / 128; u += gridDim.x) {
        const int t0 = u * 128 + ts * 16, pos0 = t0 & (SEQ - 1);
        const bf16_t* up = U + (size_t)t0 * 512 + ch * 8;
        float s[8];
#pragma unroll
        for (int i = 0; i < 8; ++i) s[i] = 0.f;
        for (int j = 1; j <= w; ++j) if (pos0 - j >= 0) { const u32x4 x = *(const u32x4*)(up - (long)j * 512);
            s[0] += bf_lo(x.x); s[1] += bf_hi(x.x); s[2] += bf_lo(x.y); s[3] += bf_hi(x.y); s[4] += bf_lo(x.z); s[5] += bf_hi(x.z); s[6] += bf_lo(x.w); s[7] += bf_hi(x.w); }
        for (int i = 0; i < 16; ++i) {
            const int pos = pos0 + i;
            const u32x4 x = *(const u32x4*)(up + (size_t)i * 512);
            const float c[8] = {bf_lo(x.x), bf_hi(x.x), bf_lo(x.y), bf_hi(x.y), bf_lo(x.z), bf_hi(x.z), bf_lo(x.w), bf_hi(x.w)};
#pragma unroll
            for (int k = 0; k < 8; ++k) s[k] += c[k];
            if (pos >= w) { const u32x4 y = *(const u32x4*)(up + (long)(i - w) * 512);
                s[0] -= bf_lo(y.x); s[1] -= bf_hi(y.x); s[2] -= bf_lo(y.y); s[3] -= bf_hi(y.y); s[4] -= bf_lo(y.z); s[5] -= bf_hi(y.z); s[6] -= bf_lo(y.w); s[7] -= bf_hi(y.w); }
            const float inv = 1.f / (float)(pos + 1 < w ? pos + 1 : w);
            u32x4 o; o.x = pk2(s[0] * inv - c[0], s[1] * inv - c[1]); o.y = pk2(s[2] * inv - c[2], s[3] * inv - c[3]); o.z = pk2(s[4] * inv - c[4], s[5] * inv - c[5]); o.w = pk2(s[6] * inv - c[6], s[7] * inv - c[7]);
            *(u32x4*)(CAT + (size_t)(t0 + i) * 1024 + 512 + ch * 8) = o;
        }
    }
}
__device__ __forceinline__ bf16x8 pack8(const f32x16& S, int o) {
    u32x4 w; w.x = pk2(S[o], S[o + 1]); w.y = pk2(S[o + 2], S[o + 3]); w.z = pk2(S[o + 4], S[o + 5]); w.w = pk2(S[o + 6], S[o + 7]);
    return __builtin_bit_cast(bf16x8, w);
}
typedef short s16x4 __attribute__((ext_vector_type(4)));
__device__ __forceinline__ s16x4 vtr(const unsigned char* p) { return __builtin_bit_cast(s16x4, __builtin_amdgcn_ds_read_tr16_b64_v4i16((LAS s16x4*)p)); }
__device__ __forceinline__ void attn_unit(unsigned char* lds, const bf16_t* __restrict__ Qg, const bf16_t* __restrict__ Kg, const bf16_t* __restrict__ Vg, const float* __restrict__ Cg,
                                          const u32x2* __restrict__ KCg, const unsigned* kmaxp, bf16_t* __restrict__ CAT, int b, int h, int qb, int tid, int lane, int wave) {
    constexpr int KS = 144, TB = 64 * KS, VS = 192, VTB = 64 * VS; constexpr float ATT_THR = 12.f;
    unsigned char* Kb = lds; unsigned char* Vb = lds + 3 * TB; u32x2* KCb = (u32x2*)(lds + 3 * TB + 3 * VTB);
    const int r32 = lane & 31, hh = lane >> 5;
    const size_t rowbase = (size_t)b * SEQ;
    const int q0 = qb * 256 + wave * 32, NT = 4 * (qb + 1);
    bf16x8 qf[4];
    { const bf16_t* qp = Qg + (rowbase + q0 + r32) * 512 + h * 64 + hh * 8;
#pragma unroll
      for (int ks = 0; ks < 4; ++ks) qf[ks] = *(const bf16x8*)(qp + ks * 16); }
    const float cq = Cg[(size_t)(b * 8 + h) * SEQ + q0 + r32];
    const unsigned qa_w = hh ? 0u : 0xBF80BF80u, qa_w2 = hh ? 0u : 0x0000BF80u, kmask = hh ? 0u : 0xffffffffu;
    const bf16x8 qaug = __builtin_bit_cast(bf16x8, (u32x4){qa_w, qa_w2, 0u, 0u});
    float ql1 = 0.f;
#pragma unroll
    for (int ks = 0; ks < 4; ++ks) { const u32x4 w = __builtin_bit_cast(u32x4, qf[ks]);
#pragma unroll
        for (int i = 0; i < 4; ++i) { const float lo = bf_lo(w[i]), hi = bf_hi(w[i]); ql1 += lo * lo + hi * hi; } }
    ql1 += __shfl_xor(ql1, 32);
#pragma unroll
    for (int o = 1; o < 32; o <<= 1) ql1 = fmaxf(ql1, __shfl_xor(ql1, o));
    float* red = (float*)(lds + 3 * TB + 3 * VTB + 2048);
    if (lane == 0) red[wave] = ql1;
    __syncthreads();
    float qmx = red[0];
#pragma unroll
    for (int w = 1; w < 8; ++w) qmx = fmaxf(qmx, red[w]);
    const float qkb = sqrtf(qmx * 2.f * __uint_as_float(__hip_atomic_load(kmaxp, __ATOMIC_RELAXED, __HIP_MEMORY_SCOPE_AGENT))) * 1.03f;
    int t_begin;
    { const float* cseq = Cg + (size_t)(b * 8 + h) * SEQ; const float cfirst = cseq[256 * qb];
      const unsigned long long b0 = __ballot((lane < NT) && ((64 * lane + 63 >= 256 * qb) || (cfirst - cseq[64 * lane + 63] + qkb >= -140.f)));
      if (b0 != 0ull) t_begin = __builtin_ctzll(b0);
      else { const int tt = lane + 64; const unsigned long long b1 = __ballot((tt < NT) && ((64 * tt + 63 >= 256 * qb) || (cfirst - cseq[64 * tt + 63] + qkb >= -140.f))); t_begin = 64 + __builtin_ctzll(b1); }
      t_begin = __builtin_amdgcn_readfirstlane(t_begin); }
    const bf16_t* ksrc = Kg + (rowbase + (tid >> 3)) * 512 + h * 64 + (tid & 7) * 8;
    const bf16_t* vsrc = Vg + (rowbase + (tid >> 3)) * 512 + h * 64 + (tid & 7) * 8;
    const u32x2* csrc = KCg + (size_t)(b * 8 + h) * SEQ;
    const int kdst = (tid >> 3) * KS + (tid & 7) * 16;
    const int vdst = (tid >> 3) * VS + (tid & 7) * 16;
    const int vtr_off = (4 * hh + ((lane & 15) >> 2)) * VS + (16 * ((lane >> 4) & 1) + 4 * (lane & 3)) * 2;
    u32x4 kreg, vreg; u32x2 creg = (u32x2){0u, 0u};
#define ATT_LOAD(tt) do { kreg = *(const u32x4*)(ksrc + (size_t)(tt) * 64 * 512); vreg = *(const u32x4*)(vsrc + (size_t)(tt) * 64 * 512); if (tid < 64) creg = csrc[(tt) * 64 + tid]; } while (0)
#define ATT_STAGE(buf) do { *(u32x4*)(Kb + (buf) * TB + kdst) = kreg; *(u32x4*)(Vb + (buf) * VTB + vdst) = vreg; \
        if (tid < 64) KCb[(buf) * 64 + tid] = creg; } while (0)
    ATT_LOAD(t_begin); ATT_STAGE(0);
    if (t_begin + 1 < NT) { ATT_LOAD(t_begin + 1); ATT_STAGE(1); }
    __syncthreads();
    bf16x8 kf[8]; u32x2 c0w, c1w;
#define ATT_KFETCH(slot) do { const unsigned char* kb_ = Kb + (slot) * TB + r32 * KS + hh * 16; \
        _Pragma("unroll") for (int ks = 0; ks < 4; ++ks) { kf[2 * ks] = *(const bf16x8*)(kb_ + ks * 32); kf[2 * ks + 1] = *(const bf16x8*)(kb_ + 32 * KS + ks * 32); } \
        c0w = KCb[(slot) * 64 + r32]; c1w = KCb[(slot) * 64 + 32 + r32]; } while (0)
    ATT_KFETCH(0);
    f32x16 O0, O1, cinit;
#pragma unroll
    for (int r = 0; r < 16; ++r) { O0[r] = 0.f; O1[r] = 0.f; cinit[r] = cq; }
    float mref = 0.f, l = 0.f;
    int s_cur = 0, s_nxt = 1, s_nn = 2;
    for (int t = t_begin; t < NT; ++t) {
        const int cur = s_cur;
        if (t + 2 < NT) ATT_LOAD(t + 2);
        if (64 * t <= q0 + 31) {
            const bf16x8 ka0 = __builtin_bit_cast(bf16x8, (u32x4){c0w.x & kmask, c0w.y & kmask, 0u, 0u}), ka1 = __builtin_bit_cast(bf16x8, (u32x4){c1w.x & kmask, c1w.y & kmask, 0u, 0u});
            __builtin_amdgcn_s_setprio(1);
            f32x16 S0 = __builtin_amdgcn_mfma_f32_32x32x16_bf16(ka0, qaug, cinit, 0, 0, 0), S1 = __builtin_amdgcn_mfma_f32_32x32x16_bf16(ka1, qaug, cinit, 0, 0, 0);
#pragma unroll
            for (int ks = 0; ks < 4; ++ks) { S0 = __builtin_amdgcn_mfma_f32_32x32x16_bf16(kf[2 * ks], qf[ks], S0, 0, 0, 0); S1 = __builtin_amdgcn_mfma_f32_32x32x16_bf16(kf[2 * ks + 1], qf[ks], S1, 0, 0, 0); }
            __builtin_amdgcn_s_setprio(0);
            if (t + 1 < NT && 64 * (t + 1) <= q0 + 31) ATT_KFETCH(s_nxt);
            if (64 * t + 63 > q0) { const int qg = q0 + r32;
#pragma unroll
                for (int r = 0; r < 16; ++r) { const int kv = 64 * t + (r & 3) + 8 * (r >> 2) + 4 * hh; if (kv > qg) S0[r] = -INFINITY; if (kv + 32 > qg) S1[r] = -INFINITY; } }
            float mx = fmaxf(fmaxf(S0[0], S1[0]), S0[1]);
#pragma unroll
            for (int r = 1; r < 16; ++r) mx = fmaxf(fmaxf(mx, S1[r]), r + 1 < 16 ? S0[r + 1] : S1[r]);
            mx = fmaxf(mx, __shfl_xor(mx, 32));
            if (__builtin_expect(__any(mx > ATT_THR), 0)) {
                const float dl = fmaxf(mx, 0.f), f = __builtin_amdgcn_exp2f(-dl); mref += dl; l *= f;
#pragma unroll
                for (int r = 0; r < 16; ++r) { S0[r] -= dl; S1[r] -= dl; O0[r] *= f; O1[r] *= f; cinit[r] = cq - mref; }
            }
            float ps = 0.f;
#pragma unroll
            for (int r = 0; r < 16; ++r) { S0[r] = __builtin_amdgcn_exp2f(S0[r]); S1[r] = __builtin_amdgcn_exp2f(S1[r]); ps += S0[r] + S1[r]; }
            l += ps;
            bf16x8 pf[4]; pf[0] = pack8(S0, 0); pf[1] = pack8(S0, 8); pf[2] = pack8(S1, 0); pf[3] = pack8(S1, 8);
            const unsigned char* vb = Vb + cur * VTB + vtr_off;
            __builtin_amdgcn_s_setprio(1);
#pragma unroll
            for (int kk = 0; kk < 4; ++kk) {
                const s16x4 l0 = vtr(vb + (16 * kk) * VS), h0 = vtr(vb + (16 * kk + 8) * VS), l1 = vtr(vb + (16 * kk) * VS + 64), h1 = vtr(vb + (16 * kk + 8) * VS + 64);
                const bf16x8 v0 = (bf16x8){l0[0], l0[1], l0[2], l0[3], h0[0], h0[1], h0[2], h0[3]}, v1 = (bf16x8){l1[0], l1[1], l1[2], l1[3], h1[0], h1[1], h1[2], h1[3]};
                O0 = __builtin_amdgcn_mfma_f32_32x32x16_bf16(v0, pf[kk], O0, 0, 0, 0); O1 = __builtin_amdgcn_mfma_f32_32x32x16_bf16(v1, pf[kk], O1, 0, 0, 0); }
            __builtin_amdgcn_s_setprio(0);
        }
        if (t + 2 < NT) ATT_STAGE(s_nn);
        __syncthreads();
        { const int tmp_ = s_cur; s_cur = s_nxt; s_nxt = s_nn; s_nn = tmp_; }
    }
#undef ATT_STAGE
#undef ATT_LOAD
#undef ATT_KFETCH
    const float inv = 1.f / (l + __shfl_xor(l, 32));
    bf16_t* op = CAT + (rowbase + q0 + r32) * 1024 + h * 64 + 4 * hh;
#pragma unroll
    for (int g = 0; g < 4; ++g) {
        u32x2 w0, w1; w0.x = pk2(O0[4 * g] * inv, O0[4 * g + 1] * inv); w0.y = pk2(O0[4 * g + 2] * inv, O0[4 * g + 3] * inv);
        w1.x = pk2(O1[4 * g] * inv, O1[4 * g + 1] * inv); w1.y = pk2(O1[4 * g + 2] * inv, O1[4 * g + 3] * inv);
        *(u32x2*)(op + 8 * g) = w0; *(u32x2*)(op + 32 + 8 * g) = w1; }
}
__device__ __forceinline__ void attn_phase(const Args& a, unsigned char* lds, int tid, int lane, int wave) {
    const bf16_t* Q = (const bf16_t*)(a.ws + WS_QKVU); const bf16_t* K = Q + (size_t)T * 512; const bf16_t* V = K + (size_t)T * 512;
    const float* C2 = (const float*)(a.ws + WS_C2); bf16_t* CAT = (bf16_t*)(a.ws + WS_CAT);
    unsigned* ctl = (unsigned*)(a.ws + WS_CTL2);
    volatile int* tk = (volatile int*)(lds + 131072 + 1024);
    const int own = (int)(__builtin_amdgcn_s_getreg((3 << 11) | 20) & 7u);
    for (int qi = 0; qi < 8; ++qi) {
        const int q = (own + qi) & 7;
        for (;;) {
            __syncthreads();
            if (wave == 0 && lane == 0) *tk = (int)__hip_atomic_fetch_add(ctl + 64 * (1 + q), 1u, __ATOMIC_RELAXED, __HIP_MEMORY_SCOPE_AGENT);
            __syncthreads();
            const int ticket = *tk;
            if (ticket >= 128) break;
            const int qb = 31 - (ticket >> 2), bh = 4 * q + (ticket & 3);
            attn_unit(lds, Q, K, V, C2, (const u32x2*)(a.ws + WS_KC), ctl + bh, CAT, bh >> 3, bh & 7, qb, tid, lane, wave);
        }
    }
}
template <bool XIN_F32, bool LAST>
__device__ __forceinline__ void ew_phase(const bf16_t* __restrict__ Mb, const float* __restrict__ xin32, const bf16_t* __restrict__ XBin, bf16_t* __restrict__ XBout, float* __restrict__ xout32,
                                         const float* __restrict__ gpost, float* __restrict__ RS, int lane, int wave) {
    const int gw = blockIdx.x * 8 + wave, NGW = gridDim.x * 8;
    f32x4 gp[4];
#pragma unroll
    for (int j = 0; j < 4; ++j) gp[j] = *(const f32x4*)(gpost + 256 * j + 4 * lane);
    for (int row0 = gw; row0 < T; row0 += 4 * NGW) {
        u32x2 mw[4][4]; u32x2 xw[4][4]; f32x4 xf[XIN_F32 ? 4 : 1][4];
#pragma unroll
        for (int k = 0; k < 4; ++k) { const int row = row0 + k * NGW; if (row < T) { const size_t off = (size_t)row * 1024 + 4 * lane;
#pragma unroll
            for (int j = 0; j < 4; ++j) { mw[k][j] = *(const u32x2*)(Mb + off + 256 * j);
                if (XIN_F32) xf[XIN_F32 ? k : 0][j] = *(const f32x4*)(xin32 + off + 256 * j); else xw[k][j] = *(const u32x2*)(XBin + off + 256 * j); } } }
#pragma unroll
        for (int k = 0; k < 4; ++k) { const int row = row0 + k * NGW; if (row < T) { const size_t off = (size_t)row * 1024 + 4 * lane;
            f32x4 mv[4], xv[4]; float ss = 0.f;
#pragma unroll
            for (int j = 0; j < 4; ++j) { mv[j] = (f32x4){bf_lo(mw[k][j].x), bf_hi(mw[k][j].x), bf_lo(mw[k][j].y), bf_hi(mw[k][j].y)};
                if (XIN_F32) xv[j] = xf[XIN_F32 ? k : 0][j]; else xv[j] = (f32x4){bf_lo(xw[k][j].x), bf_hi(xw[k][j].x), bf_lo(xw[k][j].y), bf_hi(xw[k][j].y)};
                ss += (mv[j][0] * mv[j][0] + mv[j][1] * mv[j][1]) + (mv[j][2] * mv[j][2] + mv[j][3] * mv[j][3]); }
            const float rstd = 1.f / sqrtf(wave_sum(ss) * (1.f / 1024.f) + RMS_EPS);
            float s2 = 0.f;
#pragma unroll
            for (int j = 0; j < 4; ++j) { xv[j] = xv[j] + mv[j] * rstd * gp[j];
                if (LAST) *(f32x4*)(xout32 + off + 256 * j) = xv[j];
                else { u32x2 w; w.x = pk2(xv[j][0], xv[j][1]); w.y = pk2(xv[j][2], xv[j][3]); *(u32x2*)(XBout + off + 256 * j) = w;
                    const f32x4 q = (f32x4){bf_lo(w.x), bf_hi(w.x), bf_lo(w.y), bf_hi(w.y)};
                    s2 += (q[0] * q[0] + q[1] * q[1]) + (q[2] * q[2] + q[3] * q[3]); } }
            if (!LAST) { const float r2 = 1.f / sqrtf(wave_sum(s2) * (1.f / 1024.f) + RMS_EPS); if (lane == 0) RS[row] = r2; } } }
    }
}
__device__ __forceinline__ void conv_phase(const Args& a, int tid) {
    const bf16_t* __restrict__ XR = (const bf16_t*)(a.ws + WS_XR); bf16_t* __restrict__ XC = (bf16_t*)(a.ws + WS_XC);
    const int ch = tid & 127, tq = tid >> 7, c = ch * 8;
    float w[4][8], bb[8];
#pragma unroll
    for (int i = 0; i < 8; ++i) { bb[i] = a.in[I_OD_CONVB][c + i];
#pragma unroll
        for (int j = 0; j < 4; ++j) w[j][i] = a.in[I_OD_CONVW][j * 1024 + c + i]; }
    for (int u = blockIdx.x; u < T / 128; u += gridDim.x) {
        const int t0 = u * 128 + tq * 32, pos0 = t0 & (SEQ - 1);
        float x3[8], x2[8], x1[8];
#define LDROW(dst, tt, ok) do { u32x4 x_ = (u32x4){0u, 0u, 0u, 0u}; if (ok) x_ = *(const u32x4*)(XR + (size_t)(tt) * 1024 + c); \
            dst[0] = bf_lo(x_.x); dst[1] = bf_hi(x_.x); dst[2] = bf_lo(x_.y); dst[3] = bf_hi(x_.y); dst[4] = bf_lo(x_.z); dst[5] = bf_hi(x_.z); dst[6] = bf_lo(x_.w); dst[7] = bf_hi(x_.w); } while (0)
        LDROW(x3, t0 - 3, pos0 >= 3); LDROW(x2, t0 - 2, pos0 >= 2); LDROW(x1, t0 - 1, pos0 >= 1);
        for (int i = 0; i < 32; ++i) {
            const int t = t0 + i; float x0[8]; LDROW(x0, t, true);
            float o[8];
#pragma unroll
            for (int k = 0; k < 8; ++k) { o[k] = bb[k] + w[0][k] * x3[k] + w[1][k] * x2[k] + w[2][k] * x1[k] + w[3][k] * x0[k]; x3[k] = x2[k]; x2[k] = x1[k]; x1[k] = x0[k]; }
            u32x4 ow; ow.x = pk2(o[0], o[1]); ow.y = pk2(o[2], o[3]); ow.z = pk2(o[4], o[5]); ow.w = pk2(o[6], o[7]);
            *(u32x4*)(XC + ((size_t)(c >> 8) * T + t) * 256 + (c & 255)) = ow;
        }
#undef LDROW
    }
}
#define SCAN_LD2(A, B, i0) do { _Pragma("unroll") for (int i_ = 0; i_ < 16; ++i_) { A[i_] = *(const unsigned*)(ap + (size_t)((i0) + i_) * 1024); B[i_] = *(const unsigned*)(bp + (size_t)((i0) + i_) * 1024); } } while (0)
#define SCAN_LD3(A, B, Gv, i0) do { _Pragma("unroll") for (int i_ = 0; i_ < 16; ++i_) { A[i_] = *(const unsigned*)(ap + (size_t)((i0) + i_) * 1024); B[i_] = *(const unsigned*)(bp + (size_t)((i0) + i_) * 1024); \
        Gv[i_] = *(const unsigned*)(gp + (size_t)((i0) + i_) * 1024); } } while (0)
__device__ __forceinline__ void scan1_phase(const Args& a, int tid) {
    const bf16_t* __restrict__ LA = (const bf16_t*)(a.ws + WS_A32); const bf16_t* __restrict__ BV = (const bf16_t*)(a.ws + WS_BV);
    float* __restrict__ SP = (float*)(a.ws + WS_SP); float* __restrict__ SH = (float*)(a.ws + WS_SH);
    for (int u = blockIdx.x; u < 256; u += gridDim.x) {
        const size_t t0 = (size_t)(u >> 6) * SEQ + (u & 63) * 128;
        float h0 = 0.f, h1 = 0.f, l0 = 0.f, l1 = 0.f;
        const bf16_t* ap = LA + t0 * 1024 + 2 * tid; const bf16_t* bp = BV + t0 * 1024 + 2 * tid;
        unsigned A0[16], B0[16], A1[16], B1[16];
#define SCAN1_COMP(A, B) do { _Pragma("unroll") for (int i_ = 0; i_ < 16; ++i_) { const unsigned aw = A[i_], bw = B[i_]; \
            h0 = __builtin_amdgcn_exp2f(bf_lo(aw)) * h0 + bf_lo(bw); h1 = __builtin_amdgcn_exp2f(bf_hi(aw)) * h1 + bf_hi(bw); l0 += bf_lo(aw); l1 += bf_hi(aw); } } while (0)
        SCAN_LD2(A0, B0, 0);
#pragma unroll
        for (int g = 0; g < 8; g += 2) {
            SCAN_LD2(A1, B1, (g + 1) * 16);
            SCAN1_COMP(A0, B0);
            if (g + 2 < 8) SCAN_LD2(A0, B0, (g + 2) * 16);
            SCAN1_COMP(A1, B1);
        }
#undef SCAN1_COMP
        *(f32x2*)(SP + (size_t)u * 1024 + 2 * tid) = (f32x2){__builtin_amdgcn_exp2f(l0), __builtin_amdgcn_exp2f(l1)}; *(f32x2*)(SH + (size_t)u * 1024 + 2 * tid) = (f32x2){h0, h1};
    }
}
__device__ __forceinline__ void scan2_phase(const Args& a, int tid) {
    const bf16_t* __restrict__ LA = (const bf16_t*)(a.ws + WS_A32); const bf16_t* __restrict__ BV = (const bf16_t*)(a.ws + WS_BV); const bf16_t* __restrict__ Gb = (const bf16_t*)(a.ws + WS_G);
    const float* __restrict__ SP = (const float*)(a.ws + WS_SP); const float* __restrict__ SH = (const float*)(a.ws + WS_SH); bf16_t* __restrict__ YG = (bf16_t*)(a.ws + WS_YG);
    for (int u = blockIdx.x; u < 256; u += gridDim.x) {
        const int b = u >> 6, ck = u & 63; const size_t t0 = (size_t)b * SEQ + ck * 128;
        const bf16_t* ap = LA + t0 * 1024 + 2 * tid; const bf16_t* bp = BV + t0 * 1024 + 2 * tid; const bf16_t* gp = Gb + t0 * 1024 + 2 * tid; bf16_t* yp = YG + t0 * 1024 + 2 * tid;
        unsigned A0[16], B0[16], G0[16], A1[16], B1[16], G1[16];
        SCAN_LD3(A0, B0, G0, 0);
        float h0 = 0.f, h1 = 0.f;
#pragma unroll 8
        for (int c = 0; c < ck; ++c) { const f32x2 p = *(const f32x2*)(SP + (size_t)(b * 64 + c) * 1024 + 2 * tid), s = *(const f32x2*)(SH + (size_t)(b * 64 + c) * 1024 + 2 * tid);
            h0 = p[0] * h0 + s[0]; h1 = p[1] * h1 + s[1]; }
#define SCAN2_COMP(A, B, Gv, i0) do { _Pragma("unroll") for (int i_ = 0; i_ < 16; ++i_) { const unsigned aw = A[i_], bw = B[i_], gwd = Gv[i_]; \
            h0 = __builtin_amdgcn_exp2f(bf_lo(aw)) * h0 + bf_lo(bw); h1 = __builtin_amdgcn_exp2f(bf_hi(aw)) * h1 + bf_hi(bw); \
            *(unsigned*)(yp + (size_t)((i0) + i_) * 1024) = pk2(h0 * bf_lo(gwd), h1 * bf_hi(gwd)); } } while (0)
#pragma unroll
        for (int g = 0; g < 8; g += 2) {
            SCAN_LD3(A1, B1, G1, (g + 1) * 16);
            SCAN2_COMP(A0, B0, G0, g * 16);
            if (g + 2 < 8) SCAN_LD3(A0, B0, G0, (g + 2) * 16);
            SCAN2_COMP(A1, B1, G1, (g + 1) * 16);
        }
#undef SCAN2_COMP
    }
}
#undef SCAN_LD2
#undef SCAN_LD3
__device__ __forceinline__ void grid_bar(unsigned* cnt, unsigned target, int wave_s) {
    asm volatile("s_waitcnt vmcnt(0) lgkmcnt(0)" ::: "memory");
    __syncthreads();
    if (wave_s == 0) {
        if (__builtin_amdgcn_mbcnt_hi(~0u, __builtin_amdgcn_mbcnt_lo(~0u, 0u)) == 0u) {
            __builtin_amdgcn_fence(__ATOMIC_RELEASE, "agent");
            asm volatile("s_waitcnt vmcnt(0)" ::: "memory");
            __hip_atomic_fetch_add(cnt, 1u, __ATOMIC_RELAXED, __HIP_MEMORY_SCOPE_AGENT);
            while (__hip_atomic_load(cnt, __ATOMIC_RELAXED, __HIP_MEMORY_SCOPE_AGENT) < target) __builtin_amdgcn_s_sleep(2);
        }
        __builtin_amdgcn_fence(__ATOMIC_ACQUIRE, "agent");
        asm volatile("s_waitcnt vmcnt(0)" ::: "memory");
    }
    __syncthreads();
}
#define RLX_AGENT __ATOMIC_RELAXED, __HIP_MEMORY_SCOPE_AGENT
#define XB_TMO      128
#define XB_XCNT(j)  (256  + 64 * (j))
#define XB_XSUB(j)  (1280 + 64 * (j))
#define XB_XGEN(j)  (2304 + 64 * (j))
#define XB_TOP      3328
#define XB_TOPGEN   3392
#define XCD_BAR_WORDS 3456
#define XB_SPIN_CAP (1u << 18)

__device__ __forceinline__ unsigned xb_ld(unsigned* p)              { return __hip_atomic_load(p, __ATOMIC_RELAXED, __HIP_MEMORY_SCOPE_AGENT); }
__device__ __forceinline__ unsigned xb_add(unsigned* p, unsigned v) { return __hip_atomic_fetch_add(p, v, __ATOMIC_RELAXED, __HIP_MEMORY_SCOPE_AGENT); }
__device__ __forceinline__ unsigned xb_xcc_id() { return (unsigned)__builtin_amdgcn_s_getreg((3 << 11) | 20) & 0xFu; }
#define XB_SPIN(cond, bar) do { unsigned _sp = 0; while (cond) { __builtin_amdgcn_s_sleep(1); \
    if ((++_sp & 255u) == 0u) { if (xb_ld(&(bar)[XB_TMO])) break; if (_sp > XB_SPIN_CAP) { atomicAdd(&(bar)[XB_TMO], 1u); break; } } } } while (0)

struct XcdBarrier {
    unsigned* bar; unsigned x;
    volatile LAS unsigned* st;
};

__device__ __forceinline__ XcdBarrier xcd_barrier_post(unsigned* bar, volatile LAS unsigned* st, bool is_t0) {
    XcdBarrier b; b.bar = bar; b.x = xb_xcc_id(); b.st = st;
    if (is_t0) (void)xb_add(&bar[XB_XCNT(b.x)], 1u);
    return b;
}
__device__ __forceinline__ void xcd_barrier_complete(unsigned* bar, unsigned x, unsigned& nloc, unsigned& nx) {
    const unsigned G = gridDim.x * gridDim.y * gridDim.z;
    unsigned sum, cnt, mine, sp = 0u;
    for (;;) {
        sum = 0u; cnt = 0u; mine = 0u;
#pragma unroll
        for (unsigned j = 0; j < 16; ++j) { const unsigned c = xb_ld(&bar[XB_XCNT(j)]); sum += c; cnt += (c > 0u) ? 1u : 0u; mine = (j == x) ? c : mine; }
        if (sum == G) break;
        __builtin_amdgcn_s_sleep(1);
        if ((++sp & 255u) == 0u) { if (xb_ld(&bar[XB_TMO])) break; if (sp > XB_SPIN_CAP) { atomicAdd(&bar[XB_TMO], 1u); break; } }
    }
    nloc = mine > 0u ? mine : 1u; nx = cnt > 0u ? cnt : 1u;
}

__device__ __forceinline__ void xcd_barrier(const XcdBarrier& b, bool is_t0) {
    asm volatile("s_waitcnt vmcnt(0)" ::: "memory");
    __syncthreads();
    if (is_t0) {
        unsigned* bar = b.bar;
        __builtin_amdgcn_s_waitcnt(0);
        unsigned nloc = b.st[0], nx = b.st[1];
        if (nloc == 0u) { xcd_barrier_complete(bar, b.x, nloc, nx); b.st[0] = nloc; b.st[1] = nx; }
        const unsigned old = xb_add(&bar[XB_XSUB(b.x)], 1u);
        const unsigned gen = old / nloc;
        if (old + 1u == (gen + 1u) * nloc) {
            __builtin_amdgcn_fence(__ATOMIC_RELEASE, "agent");
            asm volatile("s_waitcnt vmcnt(0)" ::: "memory");
            const unsigned og = xb_add(&bar[XB_TOP], 1u);
            const unsigned tg = og / nx;
            if (og + 1u == (tg + 1u) * nx) xb_add(&bar[XB_TOPGEN], 1u);
            else XB_SPIN(xb_ld(&bar[XB_TOPGEN]) == tg, bar);
            __builtin_amdgcn_fence(__ATOMIC_ACQUIRE, "agent");
            asm volatile("s_waitcnt vmcnt(0)" ::: "memory");
        } else {
            XB_SPIN(xb_ld(&bar[XB_TOPGEN]) == gen, bar);
            __builtin_amdgcn_fence(__ATOMIC_ACQUIRE, "agent");
            asm volatile("s_waitcnt vmcnt(0)" ::: "memory");
        }
    }
    __syncthreads();
}

__global__ void __launch_bounds__(512, 2) fwd_mega(Args a) {
    extern __shared__ __attribute__((aligned(16))) unsigned char lds[];
    cg::grid_group grid = cg::this_grid();
    const int wave_s = __builtin_amdgcn_readfirstlane((int)threadIdx.x >> 6);
    int tid, lane, wave;
    const int lo = a.ph_lo, hi = a.ph_hi, G = gridDim.x, bx = blockIdx.x;
    const bool is_t0 = (wave_s == 0) && (__builtin_amdgcn_mbcnt_hi(~0u, __builtin_amdgcn_mbcnt_lo(~0u, 0u)) == 0u);
    volatile LAS unsigned* bst = (volatile LAS unsigned*)((LAS unsigned char*)lds + 131072 + 512);
    if (is_t0) { bst[0] = 0u; bst[1] = 0u; }
    __syncthreads();
    XcdBarrier xbar; xbar.bar = (unsigned*)(a.ws + WS_BAR); xbar.x = 0; xbar.st = bst;
    unsigned char* ws = a.ws;
    PG8_LAS unsigned char* lds3 = (PG8_LAS unsigned char*)lds;
    bf16_t* XN = (bf16_t*)(ws + WS_XN); bf16_t* Mb = (bf16_t*)(ws + WS_M);
    const bool rs_in_lds = (G == 256);
    const float* RSg = (const float*)(ws + WS_RS); const LAS float* rsl = (const LAS float*)((LAS unsigned char*)lds + LDS_RS_OFF); const int rbase = 4096 * (bx & 7);
#define RS_TO_LDS() do { for (int i_ = tid; i_ < 1024; i_ += 512) ((LAS f32x4*)((LAS unsigned char*)lds + LDS_RS_OFF))[i_] = *(const f32x4*)(RSg + rbase + 4 * i_); __syncthreads(); } while (0)
#define IN(k) (lo <= (k) && (k) < hi)
#define FRESH() do { lane = (int)__builtin_amdgcn_mbcnt_hi(~0u, __builtin_amdgcn_mbcnt_lo(~0u, 0u)); asm volatile("" : "+v"(lane)); tid = wave_s * 64 + lane; wave = wave_s; } while (0)
#define SEAM(k) do { if (IN(k) && IN((k) + 1)) { if ((k) == 0) { grid.sync(); xbar = xcd_barrier_post((unsigned*)(ws + WS_BAR), bst, is_t0); } else { xcd_barrier(xbar, is_t0); if (PROBE_DUP_BAR) xcd_barrier(xbar, is_t0); } } } while (0)
    if (IN(0)) for (int rep_ = 0; rep_ <= ((PROBE_DUP_MASK >> 0) & 1); ++rep_) { if (rep_) __syncthreads(); FRESH(); if (bx == 0) for (int i_ = tid; i_ < XCD_BAR_WORDS; i_ += 512) __hip_atomic_store((unsigned*)(ws + WS_BAR) + i_, 0u, __ATOMIC_RELAXED, __HIP_MEMORY_SCOPE_AGENT); if (bx == 0) for (int i_ = tid; i_ < 64 * 9; i_ += 512) __hip_atomic_store((unsigned*)(ws + WS_CTL2) + i_, 0u, __ATOMIC_RELAXED, __HIP_MEMORY_SCOPE_AGENT); phase0(a, lds, tid, lane, wave); } SEAM(0);
    if (IN(1)) for (int rep_ = 0; rep_ <= ((PROBE_DUP_MASK >> 1) & 1); ++rep_) { if (rep_) __syncthreads(); FRESH(); cumsum_phase(a, lds, tid, lane, wave);
        pg8::Gemm g{XN, (const bf16_t*)(ws + WS_WIN0), T, 2048, 1024}; pg8::StaticOrder S; S.init(T, 2048, G, bx); if (rs_in_lds) { RS_TO_LDS(); EpiQKVU<true> E{(bf16_t*)(ws + WS_QKVU), (unsigned*)(ws + WS_CTL2), RowScale<true>{RSg, rsl, rbase}}; pg8::gemm_phase<EpiQKVU<true>, pg8::StaticOrder, true, true>(lds3, g, S, E, tid); }
        else { EpiQKVU<false> E{(bf16_t*)(ws + WS_QKVU), (unsigned*)(ws + WS_CTL2), RowScale<false>{RSg, rsl, rbase}}; pg8::gemm_phase<EpiQKVU<false>, pg8::StaticOrder, true, true>(lds3, g, S, E, tid); } } SEAM(1);
    if (IN(2)) for (int rep_ = 0; rep_ <= ((PROBE_DUP_MASK >> 2) & 1); ++rep_) { if (rep_) __syncthreads(); FRESH(); pool_phase(a, tid); attn_phase(a, lds, tid, lane, wave); } SEAM(2);
    if (IN(3)) for (int rep_ = 0; rep_ <= ((PROBE_DUP_MASK >> 3) & 1); ++rep_) { if (rep_) __syncthreads(); FRESH(); pg8::Gemm g{(const bf16_t*)(ws + WS_CAT), (const bf16_t*)(ws + WS_WOUT0), T, 1024, 1024}; pg8::StaticOrder S; S.init(T, 1024, G, bx); EpiPlain E{Mb, 1024};
        pg8::gemm_phase<EpiPlain, pg8::StaticOrder, true, true>(lds3, g, S, E, tid); } SEAM(3);
    if (IN(4)) for (int rep_ = 0; rep_ <= ((PROBE_DUP_MASK >> 4) & 1); ++rep_) { if (rep_) __syncthreads(); FRESH(); ew_phase<false, false>(Mb, nullptr, XN, XN, nullptr, a.in[I_MIX_POST], (float*)(ws + WS_RS), lane, wave); } SEAM(4);
    if (IN(5)) for (int rep_ = 0; rep_ <= ((PROBE_DUP_MASK >> 5) & 1); ++rep_) { if (rep_) __syncthreads(); FRESH(); pg8::Gemm g{XN, (const bf16_t*)(ws + WS_WGU0), T, 2 * DFF, 1024}; pg8::StaticOrder S; S.init(T, 2 * DFF, G, bx); if (rs_in_lds) { RS_TO_LDS(); EpiSwiglu<true> E{(bf16_t*)(ws + WS_H), RowScale<true>{RSg, rsl, rbase}}; pg8::gemm_phase<EpiSwiglu<true>, pg8::StaticOrder, true, true>(lds3, g, S, E, tid); }
        else { EpiSwiglu<false> E{(bf16_t*)(ws + WS_H), RowScale<false>{RSg, rsl, rbase}}; pg8::gemm_phase<EpiSwiglu<false>, pg8::StaticOrder, true, true>(lds3, g, S, E, tid); } } SEAM(5);
    if (IN(6)) for (int rep_ = 0; rep_ <= ((PROBE_DUP_MASK >> 6) & 1); ++rep_) { if (rep_) __syncthreads(); FRESH(); pg8::Gemm g{(const bf16_t*)(ws + WS_H), (const bf16_t*)(ws + WS_WD0), T, 1024, DFF}; pg8::StaticOrder S; S.init(T, 1024, G, bx); EpiPlain E{Mb, 1024};
        pg8::gemm_phase<EpiPlain, pg8::StaticOrder, true, true>(lds3, g, S, E, tid); } SEAM(6);
    if (IN(7)) for (int rep_ = 0; rep_ <= ((PROBE_DUP_MASK >> 7) & 1); ++rep_) { if (rep_) __syncthreads(); FRESH(); ew_phase<false, false>(Mb, nullptr, XN, XN, nullptr, a.in[I_FFN_POST], (float*)(ws + WS_RS), lane, wave); } SEAM(7);
    if (IN(8)) for (int rep_ = 0; rep_ <= ((PROBE_DUP_MASK >> 8) & 1); ++rep_) { if (rep_) __syncthreads(); FRESH(); pg8::Gemm g{XN, (const bf16_t*)(ws + WS_WIN1), T, 2048, 1024}; pg8::StaticOrder S; S.init(T, 2048, G, bx); if (rs_in_lds) { RS_TO_LDS(); EpiOddIn<true> E{(bf16_t*)(ws + WS_G), (bf16_t*)(ws + WS_XR), RowScale<true>{RSg, rsl, rbase}}; pg8::gemm_phase<EpiOddIn<true>, pg8::StaticOrder, true, true>(lds3, g, S, E, tid); }
        else { EpiOddIn<false> E{(bf16_t*)(ws + WS_G), (bf16_t*)(ws + WS_XR), RowScale<false>{RSg, rsl, rbase}}; pg8::gemm_phase<EpiOddIn<false>, pg8::StaticOrder, true, true>(lds3, g, S, E, tid); } } SEAM(8);
    if (IN(9)) for (int rep_ = 0; rep_ <= ((PROBE_DUP_MASK >> 9) & 1); ++rep_) { if (rep_) __syncthreads(); FRESH(); conv_phase(a, tid); } SEAM(9);
    if (IN(10)) for (int rep_ = 0; rep_ <= ((PROBE_DUP_MASK >> 10) & 1); ++rep_) { if (rep_) __syncthreads(); FRESH(); int kg = 256; asm volatile("" : "+s"(kg)); pg8::Gemm g{(const bf16_t*)(ws + WS_XC), (const bf16_t*)(ws + WS_WAX), 4 * T, 2048, kg}; GatesOrder S{G, bx};
        EpiGates E{(const bf16_t*)(ws + WS_XC), a.in[I_OD_BA], a.in[I_OD_BX], (const float*)(ws + WS_LU), (bf16_t*)(ws + WS_A32), (bf16_t*)(ws + WS_BV)};
        pg8::gemm_phase<EpiGates, GatesOrder, true, true>(lds3, g, S, E, tid); } SEAM(10);
    if (IN(11)) for (int rep_ = 0; rep_ <= ((PROBE_DUP_MASK >> 11) & 1); ++rep_) { if (rep_) __syncthreads(); FRESH(); scan1_phase(a, tid); } SEAM(11);
    if (IN(12)) for (int rep_ = 0; rep_ <= ((PROBE_DUP_MASK >> 12) & 1); ++rep_) { if (rep_) __syncthreads(); FRESH(); scan2_phase(a, tid); } SEAM(12);
    if (IN(13)) for (int rep_ = 0; rep_ <= ((PROBE_DUP_MASK >> 13) & 1); ++rep_) { if (rep_) __syncthreads(); FRESH(); pg8::Gemm g{(const bf16_t*)(ws + WS_YG), (const bf16_t*)(ws + WS_WOUT1), T, 1024, 1024}; pg8::StaticOrder S; S.init(T, 1024, G, bx); EpiPlain E{Mb, 1024};
        pg8::gemm_phase<EpiPlain, pg8::StaticOrder, true, true>(lds3, g, S, E, tid); } SEAM(13);
    if (IN(14)) for (int rep_ = 0; rep_ <= ((PROBE_DUP_MASK >> 14) & 1); ++rep_) { if (rep_) __syncthreads(); FRESH(); ew_phase<false, false>(Mb, nullptr, XN, XN, nullptr, a.in[I_MIX_POST] + 1024, (float*)(ws + WS_RS), lane, wave); } SEAM(14);
    if (IN(15)) for (int rep_ = 0; rep_ <= ((PROBE_DUP_MASK >> 15) & 1); ++rep_) { if (rep_) __syncthreads(); FRESH(); pg8::Gemm g{XN, (const bf16_t*)(ws + WS_WGU1), T, 2 * DFF, 1024}; pg8::StaticOrder S; S.init(T, 2 * DFF, G, bx); if (rs_in_lds) { RS_TO_LDS(); EpiSwiglu<true> E{(bf16_t*)(ws + WS_H), RowScale<true>{RSg, rsl, rbase}}; pg8::gemm_phase<EpiSwiglu<true>, pg8::StaticOrder, true, true>(lds3, g, S, E, tid); }
        else { EpiSwiglu<false> E{(bf16_t*)(ws + WS_H), RowScale<false>{RSg, rsl, rbase}}; pg8::gemm_phase<EpiSwiglu<false>, pg8::StaticOrder, true, true>(lds3, g, S, E, tid); } } SEAM(15);
    if (IN(16)) for (int rep_ = 0; rep_ <= ((PROBE_DUP_MASK >> 16) & 1); ++rep_) { if (rep_) __syncthreads(); FRESH(); pg8::Gemm g{(const bf16_t*)(ws + WS_H), (const bf16_t*)(ws + WS_WD1), T, 1024, DFF}; pg8::StaticOrder S; S.init(T, 1024, G, bx); EpiPlain E{Mb, 1024};
        pg8::gemm_phase<EpiPlain, pg8::StaticOrder, true, true>(lds3, g, S, E, tid); } SEAM(16);
    if (IN(17)) for (int rep_ = 0; rep_ <= ((PROBE_DUP_MASK >> 17) & 1); ++rep_) { if (rep_) __syncthreads(); FRESH(); ew_phase<false, true>(Mb, nullptr, XN, XN, a.out, a.in[I_FFN_POST] + 1024, nullptr, lane, wave); }
#undef IN
#undef SEAM
}
extern "C" void kernel_launch(void* const* d_in, const int* in_sizes, int n_in, void* d_out, int out_size, void* d_ws, size_t ws_size, hipStream_t stream) {
    static int grid = 0;
    if (grid == 0) {
        if (n_in != 22 || out_size != T * DM || ws_size < WS_END) { fprintf(stderr, "kernel_launch: unexpected problem (n_in %d out %d ws %zu)\n", n_in, out_size, ws_size); grid = -1; return; }
        int dev = 0, cus = 0, per_cu = 0;
        hipGetDevice(&dev); hipDeviceGetAttribute(&cus, hipDeviceAttributeMultiprocessorCount, dev);
        if (hipFuncSetAttribute((const void*)fwd_mega, hipFuncAttributeMaxDynamicSharedMemorySize, LDS_BYTES) != hipSuccess) { fprintf(stderr, "kernel_launch: hipFuncSetAttribute failed\n"); grid = -1; return; }
        if (hipOccupancyMaxActiveBlocksPerMultiprocessor(&per_cu, (const void*)fwd_mega, 512, LDS_BYTES) != hipSuccess || per_cu < 1) { fprintf(stderr, "kernel_launch: occupancy query says %d\n", per_cu); per_cu = 1; }
        (void)hipGetLastError();
        grid = cus * per_cu;
    }
    if (grid < 0) return;
    Args a{};
    for (int i = 0; i < 22; ++i) a.in[i] = (const float*)d_in[i];
    a.out = (float*)d_out; a.ws = (unsigned char*)d_ws;
#if MK_PER_PHASE
    for (int p = 0; p < NPHASE; ++p) { a.ph_lo = p; a.ph_hi = p + 1; hipLaunchKernelGGL(fwd_mega, dim3(grid), dim3(512), LDS_BYTES, stream, a); }
#else
    a.ph_lo = 0; a.ph_hi = NPHASE;
    void* args[] = {&a};
    hipError_t e = hipLaunchCooperativeKernel((const void*)fwd_mega, dim3(grid), dim3(512), args, LDS_BYTES, stream);
    if (e != hipSuccess) fprintf(stderr, "kernel_launch: cooperative launch failed: %s (grid %d)\n", hipGetErrorString(e), grid);
#endif
}
```

```cpp
#include <hip/hip_runtime.h>
#include <hip/hip_cooperative_groups.h>
#include <cstdio>
#include <cstdint>
#include <cmath>
namespace cg = cooperative_groups;
namespace pg8 {
#define PG8_LAS __attribute__((address_space(3)))
typedef unsigned short bf16_t;
typedef short bf16x8 __attribute__((ext_vector_type(8)));
typedef float f32x4 __attribute__((ext_vector_type(4)));
typedef unsigned u32x4 __attribute__((ext_vector_type(4)));
constexpr int BM = 256, BK = 64, HALF = 128, HTB = HALF * BK * 2  , STAGE_BYTES = 8 * HTB, NXCD = 8, WGM = 8;

__host__ __device__ __forceinline__ int lds_byte(int r, int c) { const int st = (r >> 4) * 2 + (c >> 5), rr = r & 15, cc = c & 31, ob = rr * 64 + cc * 2; return st * 1024 + (ob ^ (((ob >> 9) & 1) << 5)); }
__host__ __device__ __forceinline__ void stage_rc(int b, int& R, int& C) { const int st = b / 1024, sb = b % 1024, swz = sb ^ (((sb >> 9) & 1) << 5); R = (st >> 1) * 16 + swz / 64; C = (st & 1) * 32 + (swz % 64) / 2; }
__host__ __device__ __forceinline__ int perm32(int rho) { const int n = rho >> 4, i = rho & 15; return 8 * (i >> 2) + 4 * n + (i & 3); }

struct Unit { int pm, pn; };
struct Gemm { const bf16_t* A; const bf16_t* Bt; int M, N, K; };

struct StaticOrder {
    int nM, nN, nwg, G, c;
    __host__ __device__ void init(int M, int N, int G_, int c_) { nM = M / BM; nN = N / BM; nwg = nM * nN; G = G_; c = c_; }
    __host__ __device__ bool next(int i, Unit& u) const {
        const long L = (long)i * G + c; if (L >= nwg) return false;
        int wgid = (int)L; { const int q = nwg / NXCD, r = nwg % NXCD, xcd = wgid % NXCD, off = wgid / NXCD; wgid = (xcd < r ? xcd * (q + 1) : r * (q + 1) + (xcd - r) * q) + off; }
        const int nig = WGM * nN, gid = wgid / nig, fm = gid * WGM, gsz = (nM - fm) < WGM ? (nM - fm) : WGM;
        u.pm = fm + ((wgid % nig) % gsz); u.pn = (wgid % nig) / gsz; return true;
    }
    __device__ __forceinline__ void a_ready(const Unit&) const {}
    __device__ __forceinline__ void done(const Unit&) const {}
};

__device__ __forceinline__ unsigned cvt_pk_bf16(float lo, float hi) { unsigned r; asm volatile("v_cvt_pk_bf16_f32 %0, %1, %2" : "=v"(r) : "v"(lo), "v"(hi)); return r; }
typedef float f32x2 __attribute__((ext_vector_type(2)));
template <class Epi, class Sched, bool ALIGN_EPI = false, bool SP2 = false>
__device__ __forceinline__ void gemm_phase(PG8_LAS unsigned char* lds, const Gemm g, const Sched& S, const Epi& E, int tid_in) {
    int tid_ = tid_in; asm volatile("" : "+v"(tid_)); const int tid = tid_, wid = __builtin_amdgcn_readfirstlane(tid >> 6), lane = tid & 63, wr = wid >> 2, wc = wid & 3, fr = lane & 15, fq = lane >> 4;
    const int K = g.K, nt = K / BK;
    unsigned voffA[2], voffB[2];
#pragma unroll
    for (int i = 0; i < 2; ++i) { int R, C; stage_rc(tid * 16 + i * 8192, R, C); const int Rb = Epi::PERM ? ((R & ~31) + perm32(R & 31)) : R;
        voffA[i] = (unsigned)(R * K + C) * 2u; voffB[i] = (unsigned)(Rb * K + C) * 2u; }
    const size_t kstep = (size_t)(BK * 2);
    const size_t hstep = (size_t)HALF * K * 2;
    const size_t tstep = 2 * hstep;
    const unsigned ldsw = (unsigned)wid * 1024u;
    const int aoff = lds_byte(wr * 64 + fr, fq * 8), boff = lds_byte(wc * 32 + fr, fq * 8);
#define PG8_SA(b, h) (((b) * 2 + (h)) * HTB)
#define PG8_SB(b, h) ((4 + (b) * 2 + (h)) * HTB)
#define PG8_STAGE(bufoff, gbase, voff) do { _Pragma("unroll") for (int _i = 0; _i < 2; ++_i) \
        __builtin_amdgcn_global_load_lds((const unsigned*)((const char*)(gbase) + (voff)[_i]), (PG8_LAS unsigned*)(lds + (bufoff) + ldsw + _i * 8192), 16, 0, 0); } while (0)
#define PG8_LDA(dst, b, h) do { _Pragma("unroll") for (int m = 0; m < 4; ++m) _Pragma("unroll") for (int k = 0; k < 2; ++k) dst[m][k] = *(const PG8_LAS bf16x8*)(lds + PG8_SA(b, h) + aoff + m * 2048 + k * 1024); } while (0)
#define PG8_LDB(dst, b, h) do { _Pragma("unroll") for (int n = 0; n < 2; ++n) _Pragma("unroll") for (int k = 0; k < 2; ++k) dst[n][k] = *(const PG8_LAS bf16x8*)(lds + PG8_SB(b, h) + boff + n * 2048 + k * 1024); } while (0)
#define PG8_MMA(ai, bj, At, Bt) do { __builtin_amdgcn_s_setprio(1); _Pragma("unroll") for (int m = 0; m < 4; ++m) _Pragma("unroll") for (int n = 0; n < 2; ++n) _Pragma("unroll") for (int k = 0; k < 2; ++k) \
        acc[ai][bj][m][n] = __builtin_amdgcn_mfma_f32_16x16x32_bf16(Bt[n][k], At[m][k], acc[ai][bj][m][n], 0, 0, 0); __builtin_amdgcn_s_setprio(0); } while (0)
#define PG8_WAIT_V(n) asm volatile("s_waitcnt vmcnt(" #n ")" ::: "memory")
#define PG8_WAIT_L(n) asm volatile("s_waitcnt lgkmcnt(" #n ")" ::: "memory")
#define PG8_BAR __builtin_amdgcn_s_barrier()
#define PG8_SCHED __builtin_amdgcn_sched_barrier(0)
    Unit cur, nxt; int ui = 0;
    if (!S.next(0, cur)) return;
    f32x4 acc[2][2][4][2];
#pragma unroll
    for (int a = 0; a < 2; ++a)
#pragma unroll
        for (int b = 0; b < 2; ++b)
#pragma unroll
            for (int m = 0; m < 4; ++m)
#pragma unroll
                for (int n = 0; n < 2; ++n) acc[a][b][m][n] = (f32x4){0.f, 0.f, 0.f, 0.f};
    bf16x8 At[4][2], B0[2][2], B1[2][2];
    const char* cA = (const char*)g.A + (size_t)cur.pm * tstep; const char* cB = (const char*)g.Bt + (size_t)cur.pn * tstep;
    S.a_ready(cur);
    if constexpr (SP2) {
        PG8_STAGE(PG8_SB(0, 0), cB, voffB); PG8_STAGE(PG8_SB(0, 1), cB + hstep, voffB); PG8_STAGE(PG8_SA(0, 0), cA, voffA); PG8_STAGE(PG8_SA(0, 1), cA + hstep, voffA);
        if (wr == 1) PG8_BAR;
        PG8_WAIT_V(2); PG8_BAR;
        PG8_STAGE(PG8_SB(1, 0), cB + kstep, voffB); PG8_STAGE(PG8_SA(1, 0), cA + kstep, voffA); PG8_STAGE(PG8_SB(1, 1), cB + hstep + kstep, voffB);
        PG8_WAIT_V(6); PG8_BAR;
    } else {
        PG8_STAGE(PG8_SB(0, 0), cB, voffB); PG8_STAGE(PG8_SA(0, 0), cA, voffA); PG8_STAGE(PG8_SB(0, 1), cB + hstep, voffB); PG8_STAGE(PG8_SA(0, 1), cA + hstep, voffA);
        if (wr == 1) PG8_BAR;
        PG8_WAIT_V(4); PG8_BAR;
        PG8_STAGE(PG8_SB(1, 0), cB + kstep, voffB); PG8_STAGE(PG8_SA(1, 0), cA + kstep, voffA); PG8_STAGE(PG8_SB(1, 1), cB + hstep + kstep, voffB);
        PG8_WAIT_V(6); PG8_BAR;
    }
    for (;;) {
        const bool has_next = S.next(ui + 1, nxt);
        const char* nA = has_next ? (const char*)g.A + (size_t)nxt.pm * tstep : cA; const char* nB = has_next ? (const char*)g.Bt + (size_t)nxt.pn * tstep : cB;
        for (int t = 0; t < nt; t += 2) {
            const bool last = (t == nt - 2);
            const char* a1 = cA + (size_t)(t + 1) * kstep;
            const char* a2 = last ? nA : cA + (size_t)(t + 2) * kstep; const char* b2 = last ? nB : cB + (size_t)(t + 2) * kstep;
            const char* a3 = a2 + kstep; const char* b3 = b2 + kstep;
            if (last && has_next) S.a_ready(nxt);
            if constexpr (SP2) {
            PG8_LDB(B0, 0, 0); PG8_LDB(B1, 0, 1); PG8_SCHED; PG8_LDA(At, 0, 0); PG8_STAGE(PG8_SA(1, 1), a1 + hstep, voffA);
            PG8_WAIT_V(8); PG8_WAIT_L(0); PG8_BAR; PG8_MMA(0, 0, At, B0); PG8_MMA(0, 1, At, B1); PG8_BAR; PG8_SCHED;
            PG8_LDA(At, 0, 1); PG8_STAGE(PG8_SB(0, 0), b2, voffB); PG8_STAGE(PG8_SB(0, 1), b2 + hstep, voffB); PG8_STAGE(PG8_SA(0, 0), a2, voffA);
            PG8_WAIT_V(8); PG8_WAIT_L(0); PG8_BAR; PG8_MMA(1, 0, At, B0); PG8_MMA(1, 1, At, B1); PG8_BAR; PG8_SCHED;
            PG8_LDB(B0, 1, 0); PG8_LDB(B1, 1, 1); PG8_SCHED; PG8_LDA(At, 1, 0); PG8_STAGE(PG8_SA(0, 1), a2 + hstep, voffA);
            PG8_WAIT_V(8); PG8_WAIT_L(0); PG8_BAR; PG8_MMA(0, 0, At, B0); PG8_MMA(0, 1, At, B1); PG8_BAR; PG8_SCHED;
            PG8_LDA(At, 1, 1); PG8_STAGE(PG8_SB(1, 0), b3, voffB); PG8_STAGE(PG8_SB(1, 1), b3 + hstep, voffB); PG8_STAGE(PG8_SA(1, 0), a3, voffA);
            PG8_WAIT_V(8); PG8_WAIT_L(0); PG8_BAR; PG8_MMA(1, 0, At, B0); PG8_MMA(1, 1, At, B1); PG8_BAR; PG8_SCHED;
            } else {
            PG8_LDB(B0, 0, 0); PG8_SCHED; PG8_LDA(At, 0, 0); PG8_STAGE(PG8_SA(1, 1), a1 + hstep, voffA);
            PG8_WAIT_L(8); PG8_BAR; PG8_WAIT_L(0); PG8_MMA(0, 0, At, B0); PG8_BAR; PG8_SCHED;
            PG8_LDB(B1, 0, 1); PG8_STAGE(PG8_SB(0, 0), b2, voffB);
            PG8_BAR; PG8_WAIT_L(0); PG8_MMA(0, 1, At, B1); PG8_BAR;
            PG8_LDA(At, 0, 1); PG8_STAGE(PG8_SA(0, 0), a2, voffA);
            PG8_BAR; PG8_WAIT_L(0); PG8_MMA(1, 0, At, B0); PG8_BAR; PG8_SCHED;
            PG8_STAGE(PG8_SB(0, 1), b2 + hstep, voffB);
            PG8_WAIT_V(6); PG8_BAR; PG8_MMA(1, 1, At, B1); PG8_BAR;
            PG8_LDB(B0, 1, 0); PG8_SCHED; PG8_LDA(At, 1, 0); PG8_STAGE(PG8_SA(0, 1), a2 + hstep, voffA);
            PG8_WAIT_L(8); PG8_BAR; PG8_WAIT_L(0); PG8_MMA(0, 0, At, B0); PG8_BAR; PG8_SCHED;
            PG8_LDB(B1, 1, 1); PG8_STAGE(PG8_SB(1, 0), b3, voffB);
            PG8_BAR; PG8_WAIT_L(0); PG8_MMA(0, 1, At, B1); PG8_BAR;
            PG8_LDA(At, 1, 1); PG8_STAGE(PG8_SA(1, 0), a3, voffA);
            PG8_BAR; PG8_WAIT_L(0); PG8_MMA(1, 0, At, B0); PG8_BAR; PG8_SCHED;
            PG8_STAGE(PG8_SB(1, 1), b3 + hstep, voffB);
            PG8_WAIT_V(6); PG8_BAR; PG8_MMA(1, 1, At, B1); PG8_BAR;
            }
        }
        if constexpr (ALIGN_EPI) { if (wr == 0) PG8_BAR; }
        if constexpr (!Epi::AFTER_DRAIN) { E(acc, cur, wr, wc, fr, fq); S.done(cur); }
        if (!has_next) break;
#pragma unroll
        for (int a = 0; a < 2; ++a)
#pragma unroll
            for (int b = 0; b < 2; ++b)
#pragma unroll
                for (int m = 0; m < 4; ++m)
#pragma unroll
                    for (int n = 0; n < 2; ++n) acc[a][b][m][n] = (f32x4){0.f, 0.f, 0.f, 0.f};
        cur = nxt; cA = nA; cB = nB; ++ui;
        if constexpr (ALIGN_EPI) { if (wr == 1) PG8_BAR; }
    }
    PG8_WAIT_V(0);
    if constexpr (!ALIGN_EPI) { if (wr == 0) PG8_BAR; }
    PG8_BAR;
    if constexpr (Epi::AFTER_DRAIN) { E.fused(acc, cur, wr, wc, fr, fq, lds, wid, lane); S.done(cur); }
#undef PG8_SA
#undef PG8_SB
#undef PG8_STAGE
#undef PG8_LDA
#undef PG8_LDB
#undef PG8_MMA
#undef PG8_WAIT_V
#undef PG8_WAIT_L
#undef PG8_BAR
#undef PG8_SCHED
}
}
#ifndef PROBE_DUP_EPI
#define PROBE_DUP_EPI 0
#endif
#ifndef PROBE_EW
#define PROBE_EW 0
#endif
#ifndef PROBE_DUP_MASK
#define PROBE_DUP_MASK 0
#endif
#ifndef PROBE_DUP_BAR
#define PROBE_DUP_BAR 0
#endif
#ifndef MK_PER_PHASE
#define MK_PER_PHASE 0
#endif
using pg8::bf16_t; using pg8::bf16x8; using pg8::f32x4; using pg8::u32x4; using pg8::Unit;
typedef float f32x16 __attribute__((ext_vector_type(16)));
typedef float f32x2 __attribute__((ext_vector_type(2)));
typedef unsigned u32x2 __attribute__((ext_vector_type(2)));
#define LAS __attribute__((address_space(3)))

constexpr int BATCH = 4, SEQ = 8192, DM = 1024, T = BATCH * SEQ;
constexpr int NHEAD = 8, HD = 64, EV_IN = 2056, DFF = 2816;
constexpr float RMS_EPS = 1e-6f;
constexpr float LOG2E = 1.4426950408889634f;
constexpr float QSCALE = 0.125f * LOG2E;
constexpr int NPHASE = 18;
constexpr int LDS_BYTES = 163840;
constexpr int LDS_RS_OFF = 131072 + 2048;

constexpr size_t MiB = 1u << 20;
constexpr size_t WS_WIN0 = 0, WS_WOUT0 = 4 * MiB, WS_WGU0 = 6 * MiB, WS_WD0 = 17 * MiB, WS_WIN1 = 23 * MiB, WS_WAX = 27 * MiB, WS_WOUT1 = 28 * MiB,
                 WS_WGU1 = 30 * MiB, WS_WD1 = 41 * MiB, WS_LOGF = 47 * MiB, WS_C2 = 48 * MiB, WS_LU = 49 * MiB, WS_SP = 50 * MiB, WS_SH = 51 * MiB, WS_BAR = 52 * MiB, WS_KC = 53 * MiB, WS_CTL2 = 55 * MiB, WS_RS = 55 * MiB + 512 * 1024;
constexpr size_t WS_XN = 56 * MiB, WS_M = 120 * MiB, WS_S = 184 * MiB;
constexpr size_t WS_QKVU = WS_S, WS_CAT = WS_S + 128 * MiB, WS_H = WS_S;
constexpr size_t WS_G = WS_S, WS_XC = WS_S + 64 * MiB, WS_BV = WS_S + 128 * MiB, WS_XR = WS_S + 192 * MiB, WS_A32 = WS_S + 192 * MiB, WS_YG = WS_XC;
constexpr size_t WS_END = WS_S + 320 * MiB;

__device__ __forceinline__ unsigned pk2(float lo, float hi) { return pg8::cvt_pk_bf16(lo, hi); }
__device__ __forceinline__ float bf_lo(unsigned w) { return __uint_as_float(w << 16); }
__device__ __forceinline__ float bf_hi(unsigned w) { return __uint_as_float(w & 0xffff0000u); }
__device__ __forceinline__ float wave_sum(float v) {
#define WS_DPP(x, ctrl, rmask) __builtin_bit_cast(float, __builtin_amdgcn_update_dpp(0, __builtin_bit_cast(int, (x)), (ctrl), (rmask), 0xF, false))
    v += WS_DPP(v, 0x111, 0xF);
    v += WS_DPP(v, 0x112, 0xF);
    v += WS_DPP(v, 0x114, 0xF);
    v += WS_DPP(v, 0x118, 0xF);
    v += WS_DPP(v, 0x142, 0xA);
    v += WS_DPP(v, 0x143, 0xC);
#undef WS_DPP
    return __builtin_bit_cast(float, __builtin_amdgcn_readlane(__builtin_bit_cast(int, v), 63));
}
__device__ __forceinline__ float fast_sigmoid(float x) { return __builtin_amdgcn_rcpf(1.f + __expf(-x)); }
__device__ __forceinline__ float softplus_f(float z) { return fmaxf(z, 0.f) + log1pf(__expf(-fabsf(z))); }
__device__ __forceinline__ float gelu_tanh(float x) { const float u = 0.7978845608028654f * (x + 0.044715f * x * x * x); return x * fast_sigmoid(2.f * u); }

struct Args { const float* in[22]; float* out; unsigned char* ws; int ph_lo, ph_hi; };
enum { I_X = 0, I_MIX_PRE, I_MIX_POST, I_FFN_PRE, I_FFN_POST, I_WGATE, I_WUP, I_WDOWN, I_EV_WIN, I_EV_BF, I_EV_POOLW, I_EV_POOLS, I_EV_WOUT,
       I_OD_WIN, I_OD_CONVW, I_OD_CONVB, I_OD_WA, I_OD_BA, I_OD_WX, I_OD_BX, I_OD_LAM, I_OD_WOUT };

template <bool RSL> struct RowScale {
    const float* RS; const LAS float* rsl; int rbase;
    __device__ __forceinline__ float operator()(int row) const { if (RSL) return rsl[row - rbase]; else return RS[row]; }
};
template <bool RSL> struct EpiQKVU {
    static constexpr bool PERM = true, AFTER_DRAIN = false;
    bf16_t* O; unsigned* kmax; RowScale<RSL> RS;
    __device__ __forceinline__ void operator()(const f32x4 (&acc)[2][2][4][2], const Unit& u, int wr, int wc, int fr, int fq) const {
        const int seg = u.pn >> 1; const float sc0 = seg == 0 ? QSCALE : 1.f;
        bf16_t* base = O + (size_t)seg * T * 512 + (u.pn & 1) * 256 + wc * 32 + 8 * fq;
        const int row0 = u.pm * 256 + wr * 64 + fr;
#pragma unroll
        for (int ai = 0; ai < 2; ++ai)
#pragma unroll
            for (int m = 0; m < 4; ++m) { bf16_t* rowp = base + (size_t)(row0 + ai * 128 + m * 16) * 512; const float sc = sc0 * RS(row0 + ai * 128 + m * 16);
#pragma unroll
                for (int bj = 0; bj < 2; ++bj) { const f32x4 v0 = acc[ai][bj][m][0] * sc, v1 = acc[ai][bj][m][1] * sc;
                    u32x4 w; w.x = pk2(v0[0], v0[1]); w.y = pk2(v0[2], v0[3]); w.z = pk2(v1[0], v1[1]); w.w = pk2(v1[2], v1[3]);
                    *(u32x4*)(rowp + bj * 128) = w; } }
        if (seg == 1) {
            float mx[2] = {0.f, 0.f};
#pragma unroll
            for (int bj = 0; bj < 2; ++bj)
#pragma unroll
                for (int ai = 0; ai < 2; ++ai)
#pragma unroll
                    for (int mm = 0; mm < 4; ++mm) { const float rs = RS(row0 + ai * 128 + mm * 16); float s = 0.f;
#pragma unroll
                        for (int n = 0; n < 2; ++n)
#pragma unroll
                            for (int i = 0; i < 4; ++i) { const float v = acc[ai][bj][mm][n][i] * rs; s += v * v; }
                        s += __shfl_xor(s, 16); s += __shfl_xor(s, 32);
                        mx[bj] = fmaxf(mx[bj], s); }
#pragma unroll
            for (int o = 1; o < 16; o <<= 1) { mx[0] = fmaxf(mx[0], __shfl_xor(mx[0], o)); mx[1] = fmaxf(mx[1], __shfl_xor(mx[1], o)); }
            if (fr == 0 && fq == 0) { unsigned* kp = kmax + (u.pm >> 5) * 8 + (u.pn & 1) * 4 + (wc >> 1);
                atomicMax(kp, __float_as_uint(mx[0])); atomicMax(kp + 2, __float_as_uint(mx[1])); }
        }
    }
};
struct EpiPlain {
    static constexpr bool PERM = true, AFTER_DRAIN = false;
    bf16_t* O; int ldc;
    __device__ __forceinline__ void operator()(const f32x4 (&acc)[2][2][4][2], const Unit& u, int wr, int wc, int fr, int fq) const {
        bf16_t* base = O + u.pn * 256 + wc * 32 + 8 * fq; const int row0 = u.pm * 256 + wr * 64 + fr;
#pragma unroll
        for (int ai = 0; ai < 2; ++ai)
#pragma unroll
            for (int m = 0; m < 4; ++m) { bf16_t* rowp = base + (size_t)(row0 + ai * 128 + m * 16) * ldc;
#pragma unroll
                for (int bj = 0; bj < 2; ++bj) { const f32x4 v0 = acc[ai][bj][m][0], v1 = acc[ai][bj][m][1];
                    u32x4 w; w.x = pk2(v0[0], v0[1]); w.y = pk2(v0[2], v0[3]); w.z = pk2(v1[0], v1[1]); w.w = pk2(v1[2], v1[3]);
                    *(u32x4*)(rowp + bj * 128) = w; } }
    }
};
template <bool RSL> struct EpiSwiglu {
    static constexpr bool PERM = true, AFTER_DRAIN = false;
    bf16_t* H; RowScale<RSL> RS;
    __device__ __forceinline__ void operator()(const f32x4 (&acc)[2][2][4][2], const Unit& u, int wr, int wc, int fr, int fq) const {
        bf16_t* base = H + u.pn * 128 + wc * 32 + 8 * fq; const int row0 = u.pm * 256 + wr * 64 + fr;
        for (int rep_e = 0; rep_e <= PROBE_DUP_EPI; ++rep_e) { asm volatile("" ::: "memory");
#pragma unroll
        for (int ai = 0; ai < 2; ++ai)
#pragma unroll
            for (int m = 0; m < 4; ++m) { bf16_t* rowp = base + (size_t)(row0 + ai * 128 + m * 16) * DFF; const float rs = RS(row0 + ai * 128 + m * 16);
                float o[8];
#pragma unroll
                for (int n = 0; n < 2; ++n)
#pragma unroll
                    for (int i = 0; i < 4; ++i) { const float g = acc[ai][0][m][n][i] * rs, up = acc[ai][1][m][n][i] * rs; o[n * 4 + i] = g * fast_sigmoid(g) * up; }
                u32x4 w; w.x = pk2(o[0], o[1]); w.y = pk2(o[2], o[3]); w.z = pk2(o[4], o[5]); w.w = pk2(o[6], o[7]);
                *(u32x4*)rowp = w; }
        }
    }
};
template <bool RSL> struct EpiOddIn {
    static constexpr bool PERM = true, AFTER_DRAIN = false;
    bf16_t* G; bf16_t* XR; RowScale<RSL> RS;
    __device__ __forceinline__ void operator()(const f32x4 (&acc)[2][2][4][2], const Unit& u, int wr, int wc, int fr, int fq) const {
        const bool isg = u.pn < 4;
        bf16_t* base = (isg ? G : XR) + (u.pn & 3) * 256 + wc * 32 + 8 * fq; const int row0 = u.pm * 256 + wr * 64 + fr;
#pragma unroll
        for (int ai = 0; ai < 2; ++ai)
#pragma unroll
            for (int m = 0; m < 4; ++m) { bf16_t* rowp = base + (size_t)(row0 + ai * 128 + m * 16) * 1024; const float rs = RS(row0 + ai * 128 + m * 16);
#pragma unroll
                for (int bj = 0; bj < 2; ++bj) { f32x4 v0 = acc[ai][bj][m][0] * rs, v1 = acc[ai][bj][m][1] * rs;
                    if (isg) {
#pragma unroll
                        for (int i = 0; i < 4; ++i) { v0[i] = gelu_tanh(v0[i]); v1[i] = gelu_tanh(v1[i]); } }
                    u32x4 w; w.x = pk2(v0[0], v0[1]); w.y = pk2(v0[2], v0[3]); w.z = pk2(v1[0], v1[1]); w.w = pk2(v1[2], v1[3]);
                    *(u32x4*)(rowp + bj * 128) = w; } }
    }
};
struct EpiGates {
    static constexpr bool PERM = true, AFTER_DRAIN = false;
    const bf16_t* XC; const float* b_a; const float* b_x; const float* LU; bf16_t* LA; bf16_t* BV;
    __device__ __forceinline__ void operator()(const f32x4 (&acc)[2][2][4][2], const Unit& u, int wr, int wc, int fr, int fq) const {
        asm volatile("" : "+v"(fr), "+v"(fq));
        const int h = u.pm >> 7, j = u.pn & 1, cl = j * 128 + wc * 32 + 8 * fq, c = h * 256 + cl;
        const int t0 = (u.pm & 127) * 256 + wr * 64 + fr;
        f32x4 ba[2], bx[2], lu[2]; u32x4 xw[2][4];
#pragma unroll
        for (int n = 0; n < 2; ++n) { ba[n] = *(const f32x4*)(b_a + c + 4 * n); bx[n] = *(const f32x4*)(b_x + c + 4 * n); lu[n] = *(const f32x4*)(LU + c + 4 * n); }
#pragma unroll
        for (int ai = 0; ai < 2; ++ai)
#pragma unroll
            for (int m = 0; m < 4; ++m) xw[ai][m] = *(const u32x4*)(XC + ((size_t)h * T + t0 + ai * 128 + m * 16) * 256 + cl);
#pragma unroll
        for (int ai = 0; ai < 2; ++ai)
#pragma unroll
            for (int m = 0; m < 4; ++m) { const int t = t0 + ai * 128 + m * 16; const u32x4 x = xw[ai][m];
                const float xc[8] = {bf_lo(x.x), bf_hi(x.x), bf_lo(x.y), bf_hi(x.y), bf_lo(x.z), bf_hi(x.z), bf_lo(x.w), bf_hi(x.w)};
                float lv[8], x2v[8], gx[8], bv[8];
#pragma unroll
                for (int i = 0; i < 8; ++i) { const int n = i >> 2, e = i & 3; const float rp = acc[ai][0][m][n][e] + ba[n][e], ip = acc[ai][1][m][n][e] + bx[n][e];
                    const float r = fast_sigmoid(rp), ig = fast_sigmoid(ip); const float la = r * lu[n][e];
                    lv[i] = la * LOG2E; x2v[i] = 2.f * la; gx[i] = ig * xc[i]; }
                bool bigl = false;
#pragma unroll
                for (int i = 0; i < 8; ++i) bigl |= (x2v[i] <= -0.25f);
                const bool big = __any(bigl);
#pragma unroll
                for (int i = 0; i < 8; ++i) { const float x2 = x2v[i];
                    float om = -x2 * (1.f + x2 * (0.5f + x2 * (0.16666667f + x2 * (0.041666668f + x2 * (0.008333334f + x2 * 0.0013888889f)))));
                    if (big) { const float dr = 1.f - __expf(x2); om = x2 > -0.25f ? om : dr; }
                    bv[i] = __builtin_amdgcn_sqrtf(fmaxf(om, 0.f)) * gx[i]; }
                u32x4 lw; lw.x = pk2(lv[0], lv[1]); lw.y = pk2(lv[2], lv[3]); lw.z = pk2(lv[4], lv[5]); lw.w = pk2(lv[6], lv[7]);
                u32x4 w; w.x = pk2(bv[0], bv[1]); w.y = pk2(bv[2], bv[3]); w.z = pk2(bv[4], bv[5]); w.w = pk2(bv[6], bv[7]);
                *(u32x4*)(LA + (size_t)t * 1024 + c) = lw; *(u32x4*)(BV + (size_t)t * 1024 + c) = w; }
    }
};
struct GatesOrder {
    int G, c;
    __device__ bool next(int i, Unit& u) const { const long L = (long)i * G + c; if (L >= 1024) return false; const int l = (int)L; u.pm = l >> 1; u.pn = 2 * (u.pm >> 7) + (l & 1); return true; }
    __device__ __forceinline__ void a_ready(const Unit&) const {}
    __device__ __forceinline__ void done(const Unit&) const {}
};
__device__ __forceinline__ void tr_item(const float* __restrict__ W, int ld, int k0, int c0, bf16_t* __restrict__ WT, int Kd, int drow0, LAS float* scr, int lane, const float* __restrict__ gk = nullptr) {
    const int r8 = lane >> 3, ch = lane & 7;
    f32x4 v[8];
#pragma unroll
    for (int i = 0; i < 8; ++i) v[i] = __builtin_nontemporal_load((const f32x4*)(W + (size_t)(k0 + r8 + 8 * i) * ld + c0 + 4 * ch));
    if (gk) {
#pragma unroll
        for (int i = 0; i < 8; ++i) v[i] = v[i] * gk[k0 + r8 + 8 * i]; }
#pragma unroll
    for (int i = 0; i < 8; ++i) { LAS float* d = scr + (r8 + 8 * i) * 33 + 4 * ch; d[0] = v[i][0]; d[1] = v[i][1]; d[2] = v[i][2]; d[3] = v[i][3]; }
    asm volatile("s_waitcnt lgkmcnt(0)" ::: "memory");
    const int c = lane & 7;
#pragma unroll
    for (int j = 0; j < 4; ++j) { const int n = (lane >> 3) + 8 * j; const LAS float* s = scr + (8 * c) * 33 + n;
        u32x4 o; o.x = pk2(s[0 * 33], s[1 * 33]); o.y = pk2(s[2 * 33], s[3 * 33]); o.z = pk2(s[4 * 33], s[5 * 33]); o.w = pk2(s[6 * 33], s[7 * 33]);
        *(u32x4*)(WT + (size_t)(drow0 + n) * Kd + k0 + 8 * c) = o; }
    asm volatile("s_waitcnt lgkmcnt(0)" ::: "memory");
}
__device__ __forceinline__ void phase0(const Args& a, unsigned char* lds, int tid, int lane, int wave) {
    unsigned char* ws = a.ws;
    LAS float* scr = (LAS float*)lds + wave * 4096;
    const int gw = blockIdx.x * 8 + wave, NGW = gridDim.x * 8;
    constexpr int NITEMS = 768 + 512 + 5632 + 2816 + 1024 + 256 + 512;
    for (int it = gw; it < NITEMS; it += NGW) {
        int r = it;
        if (r < 768) { const int kb = r / 48, nb = r % 48; tr_item(a.in[I_EV_WIN], EV_IN, 64 * kb, 32 * nb, (bf16_t*)(ws + WS_WIN0), 1024, 32 * nb, scr, lane, a.in[I_MIX_PRE]); continue; } r -= 768;
        if (r < 512) { const int kb = r / 32, nb = r % 32; tr_item(a.in[I_EV_WOUT], 1024, 64 * kb, 32 * nb, (bf16_t*)(ws + WS_WOUT0), 1024, 32 * nb, scr, lane); continue; } r -= 512;
        if (r < 5632) { const int which = r / 1408; r %= 1408; const int l = which >> 1, up = which & 1, kb = r / 88, nb = r % 88, c0 = 32 * nb;
            const float* src = (up ? a.in[I_WUP] : a.in[I_WGATE]) + (size_t)l * 1024 * DFF; bf16_t* dst = (bf16_t*)(ws + (l ? WS_WGU1 : WS_WGU0));
            tr_item(src, DFF, 64 * kb, c0, dst, 1024, 256 * (c0 >> 7) + 128 * up + (c0 & 127), scr, lane, a.in[I_FFN_PRE] + l * 1024); continue; } r -= 5632;
        if (r < 2816) { const int l = r / 1408; r %= 1408; const int kb = r / 32, nb = r % 32;
            tr_item(a.in[I_WDOWN] + (size_t)l * DFF * 1024, 1024, 64 * kb, 32 * nb, (bf16_t*)(ws + (l ? WS_WD1 : WS_WD0)), DFF, 32 * nb, scr, lane); continue; } r -= 2816;
        if (r < 1024) { const int kb = r / 64, nb = r % 64; tr_item(a.in[I_OD_WIN], 2048, 64 * kb, 32 * nb, (bf16_t*)(ws + WS_WIN1), 1024, 32 * nb, scr, lane, a.in[I_MIX_PRE] + 1024); continue; } r -= 1024;
        if (r < 256) { const int which = r / 128; r %= 128; const int h = r / 32; r %= 32; const int kb = r / 8, nb = r % 8, c0 = 32 * nb;
            const float* src = (which ? a.in[I_OD_WX] : a.in[I_OD_WA]) + (size_t)h * 65536;
            tr_item(src, 256, 64 * kb, c0, (bf16_t*)(ws + WS_WAX), 256, 512 * h + 256 * (c0 >> 7) + 128 * which + (c0 & 127), scr, lane); continue; } r -= 256;
        { const int kb = r / 32, nb = r % 32; tr_item(a.in[I_OD_WOUT], 1024, 64 * kb, 32 * nb, (bf16_t*)(ws + WS_WOUT1), 1024, 32 * nb, scr, lane); }
    }
    for (int u = blockIdx.x; u < 256; u += gridDim.x) {
        const int g = u >> 6, k0 = (u & 63) * 16;
        float* As = (float*)lds; float* Wp = As + 16 * 128;
        __syncthreads();
        { const int row = tid >> 5, c4 = tid & 31; ((f32x4*)As)[tid] = *(const f32x4*)(a.in[I_EV_WIN] + (size_t)(k0 + row) * EV_IN + 1544 + g * 128 + c4 * 4); }
        for (int i = tid; i < 128 * 32; i += 512) ((f32x4*)Wp)[i] = *(const f32x4*)(a.in[I_EV_POOLW] + (size_t)g * 16384 + i * 4);
        __syncthreads();
        const int e = tid & 127, kq = tid >> 7;
        float acc[4] = {0.f, 0.f, 0.f, 0.f};
        for (int d = 0; d < 128; d += 4) {
            const float w0 = Wp[(d + 0) * 128 + e], w1 = Wp[(d + 1) * 128 + e], w2 = Wp[(d + 2) * 128 + e], w3 = Wp[(d + 3) * 128 + e];
#pragma unroll
            for (int i = 0; i < 4; ++i) { const f32x4 av = *(const f32x4*)(As + (kq * 4 + i) * 128 + d); acc[i] += av[0] * w0 + av[1] * w1 + av[2] * w2 + av[3] * w3; }
        }
        const float sc = a.in[I_EV_POOLS][g * 128 + e];
#pragma unroll
        for (int i = 0; i < 4; ++i) acc[i] *= sc * a.in[I_MIX_PRE][k0 + kq * 4 + i];
        u32x2 w; w.x = pk2(acc[0], acc[1]); w.y = pk2(acc[2], acc[3]);
        *(u32x2*)((bf16_t*)(ws + WS_WIN0) + (size_t)(1536 + g * 128 + e) * 1024 + k0 + kq * 4) = w;
    }
    if (blockIdx.x == gridDim.x - 1) for (int c = tid; c < 1024; c += 512) ((float*)(ws + WS_LU))[c] = -8.f * softplus_f(-a.in[I_OD_LAM][c]);
    __syncthreads();
    float* wf = (float*)lds;
    for (int i = tid; i < 8192; i += 512) { const int hd = i & 7, k = i >> 3; wf[hd * 1024 + k] = a.in[I_EV_WIN][(size_t)k * EV_IN + 1536 + hd]; }
    __syncthreads();
    f32x4 g4[4];
#pragma unroll
    for (int j = 0; j < 4; ++j) g4[j] = *(const f32x4*)(a.in[I_MIX_PRE] + 256 * j + 4 * lane);
    const float bfl = a.in[I_EV_BF][lane & 7];
    bf16_t* XN = (bf16_t*)(ws + WS_XN); float* LOGF = (float*)(ws + WS_LOGF);
    f32x4 vn[4];
    if (gw < T) {
#pragma unroll
        for (int j = 0; j < 4; ++j) vn[j] = __builtin_nontemporal_load((const f32x4*)(a.in[I_X] + (size_t)gw * 1024 + 4 * lane + 256 * j)); }
    for (int row = gw; row < T; row += NGW) {
        f32x4 v[4]; float ss = 0.f;
#pragma unroll
        for (int j = 0; j < 4; ++j) { v[j] = vn[j]; ss += (v[j][0] * v[j][0] + v[j][1] * v[j][1]) + (v[j][2] * v[j][2] + v[j][3] * v[j][3]); }
        if (row + NGW < T) {
#pragma unroll
            for (int j = 0; j < 4; ++j) vn[j] = __builtin_nontemporal_load((const f32x4*)(a.in[I_X] + (size_t)(row + NGW) * 1024 + 4 * lane + 256 * j)); }
        const float rstd = 1.f / sqrtf(wave_sum(ss) * (1.f / 1024.f) + RMS_EPS);
        bf16_t* xo = XN + (size_t)row * 1024 + 4 * lane;
#pragma unroll
        for (int j = 0; j < 4; ++j) { u32x2 w; w.x = pk2(v[j][0], v[j][1]); w.y = pk2(v[j][2], v[j][3]); *(u32x2*)(xo + 256 * j) = w; v[j] = v[j] * rstd * g4[j]; }
        if (lane == 0) ((float*)(ws + WS_RS))[row] = rstd;
        float d[8];
#pragma unroll
        for (int hd = 0; hd < 8; ++hd) { float s = 0.f;
#pragma unroll
            for (int j = 0; j < 4; ++j) { const f32x4 w = *(const f32x4*)(wf + hd * 1024 + 256 * j + 4 * lane); s += (v[j][0] * w[0] + v[j][1] * w[1]) + (v[j][2] * w[2] + v[j][3] * w[3]); }
            d[hd] = s; }
        float e1 = 0.f;
#pragma unroll
        for (int hd = 0; hd < 8; ++hd) { const float tsum = wave_sum(d[hd]); if ((lane & 7) == hd) e1 = tsum; }
        if (lane < 8) { const float z = e1 + bfl; LOGF[(size_t)row * 8 + lane] = fminf(z, 0.f) - log1pf(__expf(-fabsf(z))); }
    }
}
__device__ __forceinline__ void cumsum_phase(const Args& a, unsigned char* lds, int tid, int lane, int wave) {
    float* sm = (float*)lds;
    const float* LOGF = (const float*)(a.ws + WS_LOGF); float* C2 = (float*)(a.ws + WS_C2);
    for (int bh = blockIdx.x; bh < 32; bh += gridDim.x) {
        const int b = bh >> 3, hd = bh & 7;
        float v[16]; float tot = 0.f;
#pragma unroll
        for (int i = 0; i < 16; ++i) { v[i] = LOGF[((size_t)b * SEQ + tid * 16 + i) * 8 + hd]; tot += v[i]; v[i] = tot; }
        float inc = tot;
#pragma unroll
        for (int o = 1; o < 64; o <<= 1) { const float t = __shfl_up(inc, o); if (lane >= o) inc += t; }
        __syncthreads();
        if (lane == 63) sm[wave] = inc;
        __syncthreads();
        float base = 0.f;
        for (int w = 0; w < wave; ++w) base += sm[w];
        const float excl = base + inc - tot;
        float* o = C2 + (size_t)bh * SEQ + tid * 16;
        u32x2* kc = (u32x2*)(a.ws + WS_KC) + (size_t)bh * SEQ + tid * 16;
#pragma unroll
        for (int i = 0; i < 16; ++i) { const float c = (excl + v[i]) * LOG2E; o[i] = c;
            const unsigned hi = pk2(c, 0.f) & 0xffffu; const float r1 = c - bf_lo(hi); const unsigned mid = pk2(r1, 0.f) & 0xffffu; const float r2 = r1 - bf_lo(mid); const unsigned lo = pk2(r2, 0.f) & 0xffffu;
            u32x2 w; w.x = hi | (mid << 16); w.y = lo; kc[i] = w; }
    }
    __syncthreads();
}
__device__ __forceinline__ void pool_phase(const Args& a, int tid) {
    const bf16_t* __restrict__ U = (const bf16_t*)(a.ws + WS_QKVU) + (size_t)3 * T * 512; bf16_t* __restrict__ CAT = (bf16_t*)(a.ws + WS_CAT);
    const int ch = tid & 63, ts = tid >> 6, g = ch >> 4, w = 2 << g;
    for (int u = blockIdx.x; u < T / 128; u += gridDim.x) {
        const int t0 = u * 128 + ts * 16, pos0 = t0 & (SEQ - 1);
        const bf16_t* up = U + (size_t)t0 * 512 + ch * 8;
        float s[8];
#pragma unroll
        for (int i = 0; i < 8; ++i) s[i] = 0.f;
        for (int j = 1; j <= w; ++j) if (pos0 - j >= 0) { const u32x4 x = *(const u32x4*)(up - (long)j * 512);
            s[0] += bf_lo(x.x); s[1] += bf_hi(x.x); s[2] += bf_lo(x.y); s[3] += bf_hi(x.y); s[4] += bf_lo(x.z); s[5] += bf_hi(x.z); s[6] += bf_lo(x.w); s[7] += bf_hi(x.w); }
        for (int i = 0; i < 16; ++i) {
            const int pos = pos0 + i;
            const u32x4 x = *(const u32x4*)(up + (size_t)i * 512);
            const float c[8] = {bf_lo(x.x), bf_hi(x.x), bf_lo(x.y), bf_hi(x.y), bf_lo(x.z), bf_hi(x.z), bf_lo(x.w), bf_hi(x.w)};
#pragma unroll
            for (int k = 0; k < 8; ++k) s[k] += c[k];
            if (pos >= w) { const u32x4 y = *(const u32x4*)(up + (long)(i - w) * 512);
                s[0] -= bf_lo(y.x); s[1] -= bf_hi(y.x); s[2] -= bf_lo(y.y); s[3] -= bf_hi(y.y); s[4] -= bf_lo(y.z); s[5] -= bf_hi(y.z); s[6] -= bf_lo(y.w); s[7] -= bf_hi(y.w); }
            const float inv = 1.f / (float)(pos + 1 < w ? pos + 1 : w);
            u32x4 o; o.x = pk2(s[0] * inv - c[0], s[1] * inv - c[1]); o.y = pk2(s[2] * inv - c[2], s[3] * inv - c[3]); o.z = pk2(s[4] * inv - c[4], s[5] * inv - c[5]); o.w = pk2(s[6] * inv - c[6], s[7] * inv - c[7]);
            *(u32x4*)(CAT + (size_t)(t0 + i) * 1024 + 512 + ch * 8) = o;
        }
    }
}
__device__ __forceinline__ bf16x8 pack8(const f32x16& S, int o) {
    u32x4 w; w.x = pk2(S[o], S[o + 1]); w.y = pk2(S[o + 2], S[o + 3]); w.z = pk2(S[o + 4], S[o + 5]); w.w = pk2(S[o + 6], S[o + 7]);
    return __builtin_bit_cast(bf16x8, w);
}
typedef short s16x4 __attribute__((ext_vector_type(4)));
__device__ __forceinline__ s16x4 vtr(const unsigned char* p) { return __builtin_bit_cast(s16x4, __builtin_amdgcn_ds_read_tr16_b64_v4i16((LAS s16x4*)p)); }
__device__ __forceinline__ void attn_unit(unsigned char* lds, const bf16_t* __restrict__ Qg, const bf16_t* __restrict__ Kg, const bf16_t* __restrict__ Vg, const float* __restrict__ Cg,
                                          const u32x2* __restrict__ KCg, const unsigned* kmaxp, bf16_t* __restrict__ CAT, int b, int h, int qb, int tid, int lane, int wave) {
    constexpr int KS = 144, TB = 64 * KS, VS = 192, VTB = 64 * VS; constexpr float ATT_THR = 12.f;
    unsigned char* Kb = lds; unsigned char* Vb = lds + 2 * TB; u32x2* KCb = (u32x2*)(lds + 2 * TB + 2 * VTB);
    const int r32 = lane & 31, hh = lane >> 5;
    const size_t rowbase = (size_t)b * SEQ;
    const int q0 = qb * 256 + wave * 32, NT = 4 * (qb + 1);
    bf16x8 qf[4];
    { const bf16_t* qp = Qg + (rowbase + q0 + r32) * 512 + h * 64 + hh * 8;
#pragma unroll
      for (int ks = 0; ks < 4; ++ks) qf[ks] = *(const bf16x8*)(qp + ks * 16); }
    const float cq = Cg[(size_t)(b * 8 + h) * SEQ + q0 + r32];
    const unsigned qa_w = hh ? 0u : 0xBF80BF80u, qa_w2 = hh ? 0u : 0x0000BF80u, kmask = hh ? 0u : 0xffffffffu;
    const bf16x8 qaug = __builtin_bit_cast(bf16x8, (u32x4){qa_w, qa_w2, 0u, 0u});
    float ql1 = 0.f;
#pragma unroll
    for (int ks = 0; ks < 4; ++ks) { const u32x4 w = __builtin_bit_cast(u32x4, qf[ks]);
#pragma unroll
        for (int i = 0; i < 4; ++i) { const float lo = bf_lo(w[i]), hi = bf_hi(w[i]); ql1 += lo * lo + hi * hi; } }
    ql1 += __shfl_xor(ql1, 32);
#pragma unroll
    for (int o = 1; o < 32; o <<= 1) ql1 = fmaxf(ql1, __shfl_xor(ql1, o));
    float* red = (float*)(lds + 2 * TB + 2 * VTB + 1024);
    if (lane == 0) red[wave] = ql1;
    __syncthreads();
    float qmx = red[0];
#pragma unroll
    for (int w = 1; w < 8; ++w) qmx = fmaxf(qmx, red[w]);
    const float qkb = sqrtf(qmx * 2.f * __uint_as_float(__hip_atomic_load(kmaxp, __ATOMIC_RELAXED, __HIP_MEMORY_SCOPE_AGENT))) * 1.03f;
    int t_begin;
    { const float* cseq = Cg + (size_t)(b * 8 + h) * SEQ; const float cfirst = cseq[256 * qb];
      const unsigned long long b0 = __ballot((lane < NT) && ((64 * lane + 63 >= 256 * qb) || (cfirst - cseq[64 * lane + 63] + qkb >= -140.f)));
      if (b0 != 0ull) t_begin = __builtin_ctzll(b0);
      else { const int tt = lane + 64; const unsigned long long b1 = __ballot((tt < NT) && ((64 * tt + 63 >= 256 * qb) || (cfirst - cseq[64 * tt + 63] + qkb >= -140.f))); t_begin = 64 + __builtin_ctzll(b1); }
      t_begin = __builtin_amdgcn_readfirstlane(t_begin); }
    const bf16_t* ksrc = Kg + (rowbase + (tid >> 3)) * 512 + h * 64 + (tid & 7) * 8;
    const bf16_t* vsrc = Vg + (rowbase + (tid >> 3)) * 512 + h * 64 + (tid & 7) * 8;
    const u32x2* csrc = KCg + (size_t)(b * 8 + h) * SEQ;
    const int kdst = (tid >> 3) * KS + (tid & 7) * 16;
    const int vdst = (tid >> 3) * VS + (tid & 7) * 16;
    const int vtr_off = (4 * hh + ((lane & 15) >> 2)) * VS + (16 * ((lane >> 4) & 1) + 4 * (lane & 3)) * 2;
    u32x4 kreg, vreg; u32x2 creg = (u32x2){0u, 0u};
    kreg = *(const u32x4*)(ksrc + (size_t)t_begin * 64 * 512); vreg = *(const u32x4*)(vsrc + (size_t)t_begin * 64 * 512); if (tid < 64) creg = csrc[t_begin * 64 + tid];
#define ATT_STAGE(buf) do { *(u32x4*)(Kb + (buf) * TB + kdst) = kreg; *(u32x4*)(Vb + (buf) * VTB + vdst) = vreg; \
        if (tid < 64) KCb[(buf) * 64 + tid] = creg; } while (0)
    ATT_STAGE(t_begin & 1);
    __syncthreads();
    f32x16 O0, O1, cinit;
#pragma unroll
    for (int r = 0; r < 16; ++r) { O0[r] = 0.f; O1[r] = 0.f; cinit[r] = cq; }
    float mref = 0.f, l = 0.f;
    for (int t = t_begin; t < NT; ++t) {
        const int cur = t & 1;
        if (t + 1 < NT) { kreg = *(const u32x4*)(ksrc + (size_t)(t + 1) * 64 * 512); vreg = *(const u32x4*)(vsrc + (size_t)(t + 1) * 64 * 512); if (tid < 64) creg = csrc[(t + 1) * 64 + tid]; }
        if (64 * t <= q0 + 31) {
            const unsigned char* kb = Kb + cur * TB + r32 * KS + hh * 16;
            const u32x2 c0w = KCb[cur * 64 + r32], c1w = KCb[cur * 64 + 32 + r32];
            const bf16x8 ka0 = __builtin_bit_cast(bf16x8, (u32x4){c0w.x & kmask, c0w.y & kmask, 0u, 0u}), ka1 = __builtin_bit_cast(bf16x8, (u32x4){c1w.x & kmask, c1w.y & kmask, 0u, 0u});
            __builtin_amdgcn_s_setprio(1);
            f32x16 S0 = __builtin_amdgcn_mfma_f32_32x32x16_bf16(ka0, qaug, cinit, 0, 0, 0), S1 = __builtin_amdgcn_mfma_f32_32x32x16_bf16(ka1, qaug, cinit, 0, 0, 0);
#pragma unroll
            for (int ks = 0; ks < 4; ++ks) { const bf16x8 k0 = *(const bf16x8*)(kb + ks * 32), k1 = *(const bf16x8*)(kb + 32 * KS + ks * 32);
                S0 = __builtin_amdgcn_mfma_f32_32x32x16_bf16(k0, qf[ks], S0, 0, 0, 0); S1 = __builtin_amdgcn_mfma_f32_32x32x16_bf16(k1, qf[ks], S1, 0, 0, 0); }
            __builtin_amdgcn_s_setprio(0);
            if (64 * t + 63 > q0) { const int qg = q0 + r32;
#pragma unroll
                for (int r = 0; r < 16; ++r) { const int kv = 64 * t + (r & 3) + 8 * (r >> 2) + 4 * hh; if (kv > qg) S0[r] = -INFINITY; if (kv + 32 > qg) S1[r] = -INFINITY; } }
            float mx = fmaxf(fmaxf(S0[0], S1[0]), S0[1]);
#pragma unroll
            for (int r = 1; r < 16; ++r) mx = fmaxf(fmaxf(mx, S1[r]), r + 1 < 16 ? S0[r + 1] : S1[r]);
            mx = fmaxf(mx, __shfl_xor(mx, 32));
            if (__builtin_expect(__any(mx > ATT_THR), 0)) {
                const float dl = fmaxf(mx, 0.f), f = __builtin_amdgcn_exp2f(-dl); mref += dl; l *= f;
#pragma unroll
                for (int r = 0; r < 16; ++r) { S0[r] -= dl; S1[r] -= dl; O0[r] *= f; O1[r] *= f; cinit[r] = cq - mref; }
            }
            float ps = 0.f;
#pragma unroll
            for (int r = 0; r < 16; ++r) { S0[r] = __builtin_amdgcn_exp2f(S0[r]); S1[r] = __builtin_amdgcn_exp2f(S1[r]); ps += S0[r] + S1[r]; }
            l += ps;
            bf16x8 pf[4]; pf[0] = pack8(S0, 0); pf[1] = pack8(S0, 8); pf[2] = pack8(S1, 0); pf[3] = pack8(S1, 8);
            const unsigned char* vb = Vb + cur * VTB + vtr_off;
            __builtin_amdgcn_s_setprio(1);
#pragma unroll
            for (int kk = 0; kk < 4; ++kk) {
                const s16x4 l0 = vtr(vb + (16 * kk) * VS), h0 = vtr(vb + (16 * kk + 8) * VS), l1 = vtr(vb + (16 * kk) * VS + 64), h1 = vtr(vb + (16 * kk + 8) * VS + 64);
                const bf16x8 v0 = (bf16x8){l0[0], l0[1], l0[2], l0[3], h0[0], h0[1], h0[2], h0[3]}, v1 = (bf16x8){l1[0], l1[1], l1[2], l1[3], h1[0], h1[1], h1[2], h1[3]};
                O0 = __builtin_amdgcn_mfma_f32_32x32x16_bf16(v0, pf[kk], O0, 0, 0, 0); O1 = __builtin_amdgcn_mfma_f32_32x32x16_bf16(v1, pf[kk], O1, 0, 0, 0); }
            __builtin_amdgcn_s_setprio(0);
        }
        if (t + 1 < NT) ATT_STAGE(cur ^ 1);
        __syncthreads();
    }
#undef ATT_STAGE
    const float inv = 1.f / (l + __shfl_xor(l, 32));
    bf16_t* op = CAT + (rowbase + q0 + r32) * 1024 + h * 64 + 4 * hh;
#pragma unroll
    for (int g = 0; g < 4; ++g) {
        u32x2 w0, w1; w0.x = pk2(O0[4 * g] * inv, O0[4 * g + 1] * inv); w0.y = pk2(O0[4 * g + 2] * inv, O0[4 * g + 3] * inv);
        w1.x = pk2(O1[4 * g] * inv, O1[4 * g + 1] * inv); w1.y = pk2(O1[4 * g + 2] * inv, O1[4 * g + 3] * inv);
        *(u32x2*)(op + 8 * g) = w0; *(u32x2*)(op + 32 + 8 * g) = w1; }
}
__device__ __forceinline__ void attn_phase(const Args& a, unsigned char* lds, int tid, int lane, int wave) {
    const bf16_t* Q = (const bf16_t*)(a.ws + WS_QKVU); const bf16_t* K = Q + (size_t)T * 512; const bf16_t* V = K + (size_t)T * 512;
    const float* C2 = (const float*)(a.ws + WS_C2); bf16_t* CAT = (bf16_t*)(a.ws + WS_CAT);
    unsigned* ctl = (unsigned*)(a.ws + WS_CTL2);
    volatile int* tk = (volatile int*)(lds + 131072 + 1024);
    const int own = (int)(__builtin_amdgcn_s_getreg((3 << 11) | 20) & 7u);
    for (int qi = 0; qi < 8; ++qi) {
        const int q = (own + qi) & 7;
        for (;;) {
            __syncthreads();
            if (wave == 0 && lane == 0) *tk = (int)__hip_atomic_fetch_add(ctl + 64 * (1 + q), 1u, __ATOMIC_RELAXED, __HIP_MEMORY_SCOPE_AGENT);
            __syncthreads();
            const int ticket = *tk;
            if (ticket >= 128) break;
            const int qb = 31 - (ticket >> 2), bh = 4 * q + (ticket & 3);
            attn_unit(lds, Q, K, V, C2, (const u32x2*)(a.ws + WS_KC), ctl + bh, CAT, bh >> 3, bh & 7, qb, tid, lane, wave);
        }
    }
}
template <bool XIN_F32, bool LAST>
__device__ __forceinline__ void ew_phase(const bf16_t* __restrict__ Mb, const float* __restrict__ xin32, const bf16_t* __restrict__ XBin, bf16_t* __restrict__ XBout, float* __restrict__ xout32,
                                         const float* __restrict__ gpost, float* __restrict__ RS, int lane, int wave) {
    const int gw = blockIdx.x * 8 + wave, NGW = gridDim.x * 8;
    f32x4 gp[4];
#pragma unroll
    for (int j = 0; j < 4; ++j) gp[j] = *(const f32x4*)(gpost + 256 * j + 4 * lane);
    for (int row0 = gw; row0 < T; row0 += 4 * NGW) {
        u32x2 mw[4][4]; u32x2 xw[4][4]; f32x4 xf[XIN_F32 ? 4 : 1][4];
#pragma unroll
        for (int k = 0; k < 4; ++k) { const int row = row0 + k * NGW; if (row < T) { const size_t off = (size_t)row * 1024 + 4 * lane;
#pragma unroll
            for (int j = 0; j < 4; ++j) { mw[k][j] = __builtin_nontemporal_load((const u32x2*)(Mb + off + 256 * j));
                if (XIN_F32) xf[XIN_F32 ? k : 0][j] = *(const f32x4*)(xin32 + off + 256 * j); else xw[k][j] = *(const u32x2*)(XBin + off + 256 * j); } } }
#pragma unroll
        for (int k = 0; k < 4; ++k) { const int row = row0 + k * NGW; if (row < T) { const size_t off = (size_t)row * 1024 + 4 * lane;
            f32x4 mv[4], xv[4]; float ss = 0.f;
#pragma unroll
            for (int j = 0; j < 4; ++j) { mv[j] = (f32x4){bf_lo(mw[k][j].x), bf_hi(mw[k][j].x), bf_lo(mw[k][j].y), bf_hi(mw[k][j].y)};
                if (XIN_F32) xv[j] = xf[XIN_F32 ? k : 0][j]; else xv[j] = (f32x4){bf_lo(xw[k][j].x), bf_hi(xw[k][j].x), bf_lo(xw[k][j].y), bf_hi(xw[k][j].y)};
                ss += (mv[j][0] * mv[j][0] + mv[j][1] * mv[j][1]) + (mv[j][2] * mv[j][2] + mv[j][3] * mv[j][3]); }
            const float rstd = 1.f / sqrtf(wave_sum(ss) * (1.f / 1024.f) + RMS_EPS);
            float s2 = 0.f;
#pragma unroll
            for (int j = 0; j < 4; ++j) { xv[j] = xv[j] + mv[j] * rstd * gp[j];
                if (LAST) __builtin_nontemporal_store(xv[j], (f32x4*)(xout32 + off + 256 * j));
                else { u32x2 w; w.x = pk2(xv[j][0], xv[j][1]); w.y = pk2(xv[j][2], xv[j][3]); *(u32x2*)(XBout + off + 256 * j) = w;
                    const f32x4 q = (f32x4){bf_lo(w.x), bf_hi(w.x), bf_lo(w.y), bf_hi(w.y)};
                    s2 += (q[0] * q[0] + q[1] * q[1]) + (q[2] * q[2] + q[3] * q[3]); } }
            if (!LAST) { const float r2 = 1.f / sqrtf(wave_sum(s2) * (1.f / 1024.f) + RMS_EPS); if (lane == 0) RS[row] = r2; } } }
    }
}
__device__ __forceinline__ void conv_phase(const Args& a, int tid) {
    const bf16_t* __restrict__ XR = (const bf16_t*)(a.ws + WS_XR); bf16_t* __restrict__ XC = (bf16_t*)(a.ws + WS_XC);
    const int ch = tid & 127, tq = tid >> 7, c = ch * 8;
    float w[4][8], bb[8];
#pragma unroll
    for (int i = 0; i < 8; ++i) { bb[i] = a.in[I_OD_CONVB][c + i];
#pragma unroll
        for (int j = 0; j < 4; ++j) w[j][i] = a.in[I_OD_CONVW][j * 1024 + c + i]; }
    for (int u = blockIdx.x; u < T / 128; u += gridDim.x) {
        const int t0 = u * 128 + tq * 32, pos0 = t0 & (SEQ - 1);
        float x3[8], x2[8], x1[8];
#define LDROW(dst, tt, ok) do { u32x4 x_ = (u32x4){0u, 0u, 0u, 0u}; if (ok) x_ = __builtin_nontemporal_load((const u32x4*)(XR + (size_t)(tt) * 1024 + c)); \
            dst[0] = bf_lo(x_.x); dst[1] = bf_hi(x_.x); dst[2] = bf_lo(x_.y); dst[3] = bf_hi(x_.y); dst[4] = bf_lo(x_.z); dst[5] = bf_hi(x_.z); dst[6] = bf_lo(x_.w); dst[7] = bf_hi(x_.w); } while (0)
        LDROW(x3, t0 - 3, pos0 >= 3); LDROW(x2, t0 - 2, pos0 >= 2); LDROW(x1, t0 - 1, pos0 >= 1);
        for (int i = 0; i < 32; ++i) {
            const int t = t0 + i; float x0[8]; LDROW(x0, t, true);
            float o[8];
#pragma unroll
            for (int k = 0; k < 8; ++k) { o[k] = bb[k] + w[0][k] * x3[k] + w[1][k] * x2[k] + w[2][k] * x1[k] + w[3][k] * x0[k]; x3[k] = x2[k]; x2[k] = x1[k]; x1[k] = x0[k]; }
            u32x4 ow; ow.x = pk2(o[0], o[1]); ow.y = pk2(o[2], o[3]); ow.z = pk2(o[4], o[5]); ow.w = pk2(o[6], o[7]);
            *(u32x4*)(XC + ((size_t)(c >> 8) * T + t) * 256 + (c & 255)) = ow;
        }
#undef LDROW
    }
}
#define SCAN_LD2(A, B, i0) do { _Pragma("unroll") for (int i_ = 0; i_ < 16; ++i_) { A[i_] = *(const unsigned*)(ap + (size_t)((i0) + i_) * 1024); B[i_] = *(const unsigned*)(bp + (size_t)((i0) + i_) * 1024); } } while (0)
#define SCAN_LD3(A, B, Gv, i0) do { _Pragma("unroll") for (int i_ = 0; i_ < 16; ++i_) { A[i_] = *(const unsigned*)(ap + (size_t)((i0) + i_) * 1024); B[i_] = *(const unsigned*)(bp + (size_t)((i0) + i_) * 1024); \
        Gv[i_] = __builtin_nontemporal_load((const unsigned*)(gp + (size_t)((i0) + i_) * 1024)); } } while (0)
__device__ __forceinline__ void scan1_phase(const Args& a, int tid) {
    const bf16_t* __restrict__ LA = (const bf16_t*)(a.ws + WS_A32); const bf16_t* __restrict__ BV = (const bf16_t*)(a.ws + WS_BV);
    float* __restrict__ SP = (float*)(a.ws + WS_SP); float* __restrict__ SH = (float*)(a.ws + WS_SH);
    for (int u = blockIdx.x; u < 256; u += gridDim.x) {
        const size_t t0 = (size_t)(u >> 6) * SEQ + (u & 63) * 128;
        float h0 = 0.f, h1 = 0.f, l0 = 0.f, l1 = 0.f;
        const bf16_t* ap = LA + t0 * 1024 + 2 * tid; const bf16_t* bp = BV + t0 * 1024 + 2 * tid;
        unsigned A0[16], B0[16], A1[16], B1[16];
#define SCAN1_COMP(A, B) do { _Pragma("unroll") for (int i_ = 0; i_ < 16; ++i_) { const unsigned aw = A[i_], bw = B[i_]; \
            h0 = __builtin_amdgcn_exp2f(bf_lo(aw)) * h0 + bf_lo(bw); h1 = __builtin_amdgcn_exp2f(bf_hi(aw)) * h1 + bf_hi(bw); l0 += bf_lo(aw); l1 += bf_hi(aw); } } while (0)
        SCAN_LD2(A0, B0, 0);
#pragma unroll
        for (int g = 0; g < 8; g += 2) {
            SCAN_LD2(A1, B1, (g + 1) * 16);
            SCAN1_COMP(A0, B0);
            if (g + 2 < 8) SCAN_LD2(A0, B0, (g + 2) * 16);
            SCAN1_COMP(A1, B1);
        }
#undef SCAN1_COMP
        *(f32x2*)(SP + (size_t)u * 1024 + 2 * tid) = (f32x2){__builtin_amdgcn_exp2f(l0), __builtin_amdgcn_exp2f(l1)}; *(f32x2*)(SH + (size_t)u * 1024 + 2 * tid) = (f32x2){h0, h1};
    }
}
__device__ __forceinline__ void scan2_phase(const Args& a, int tid) {
    const bf16_t* __restrict__ LA = (const bf16_t*)(a.ws + WS_A32); const bf16_t* __restrict__ BV = (const bf16_t*)(a.ws + WS_BV); const bf16_t* __restrict__ Gb = (const bf16_t*)(a.ws + WS_G);
    const float* __restrict__ SP = (const float*)(a.ws + WS_SP); const float* __restrict__ SH = (const float*)(a.ws + WS_SH); bf16_t* __restrict__ YG = (bf16_t*)(a.ws + WS_YG);
    for (int u = blockIdx.x; u < 256; u += gridDim.x) {
        const int b = u >> 6, ck = u & 63; const size_t t0 = (size_t)b * SEQ + ck * 128;
        const bf16_t* ap = LA + t0 * 1024 + 2 * tid; const bf16_t* bp = BV + t0 * 1024 + 2 * tid; const bf16_t* gp = Gb + t0 * 1024 + 2 * tid; bf16_t* yp = YG + t0 * 1024 + 2 * tid;
        unsigned A0[16], B0[16], G0[16], A1[16], B1[16], G1[16];
        SCAN_LD3(A0, B0, G0, 0);
        float h0 = 0.f, h1 = 0.f;
#pragma unroll 8
        for (int c = 0; c < ck; ++c) { const f32x2 p = *(const f32x2*)(SP + (size_t)(b * 64 + c) * 1024 + 2 * tid), s = *(const f32x2*)(SH + (size_t)(b * 64 + c) * 1024 + 2 * tid);
            h0 = p[0] * h0 + s[0]; h1 = p[1] * h1 + s[1]; }
#define SCAN2_COMP(A, B, Gv, i0) do { _Pragma("unroll") for (int i_ = 0; i_ < 16; ++i_) { const unsigned aw = A[i_], bw = B[i_], gwd = Gv[i_]; \
            h0 = __builtin_amdgcn_exp2f(bf_lo(aw)) * h0 + bf_lo(bw); h1 = __builtin_amdgcn_exp2f(bf_hi(aw)) * h1 + bf_hi(bw); \
            *(unsigned*)(yp + (size_t)((i0) + i_) * 1024) = pk2(h0 * bf_lo(gwd), h1 * bf_hi(gwd)); } } while (0)
#pragma unroll
        for (int g = 0; g < 8; g += 2) {
            SCAN_LD3(A1, B1, G1, (g + 1) * 16);
            SCAN2_COMP(A0, B0, G0, g * 16);
            if (g + 2 < 8) SCAN_LD3(A0, B0, G0, (g + 2) * 16);
            SCAN2_COMP(A1, B1, G1, (g + 1) * 16);
        }
#undef SCAN2_COMP
    }
}
#undef SCAN_LD2
#undef SCAN_LD3
__device__ __forceinline__ void grid_bar(unsigned* cnt, unsigned target, int wave_s) {
    asm volatile("s_waitcnt vmcnt(0) lgkmcnt(0)" ::: "memory");
    __syncthreads();
    if (wave_s == 0) {
        if (__builtin_amdgcn_mbcnt_hi(~0u, __builtin_amdgcn_mbcnt_lo(~0u, 0u)) == 0u) {
            __builtin_amdgcn_fence(__ATOMIC_RELEASE, "agent");
            asm volatile("s_waitcnt vmcnt(0)" ::: "memory");
            __hip_atomic_fetch_add(cnt, 1u, __ATOMIC_RELAXED, __HIP_MEMORY_SCOPE_AGENT);
            while (__hip_atomic_load(cnt, __ATOMIC_RELAXED, __HIP_MEMORY_SCOPE_AGENT) < target) __builtin_amdgcn_s_sleep(2);
        }
        __builtin_amdgcn_fence(__ATOMIC_ACQUIRE, "agent");
        asm volatile("s_waitcnt vmcnt(0)" ::: "memory");
    }
    __syncthreads();
}
#define RLX_AGENT __ATOMIC_RELAXED, __HIP_MEMORY_SCOPE_AGENT
#define XB_TMO      128
#define XB_XCNT(j)  (256  + 64 * (j))
#define XB_XSUB(j)  (1280 + 64 * (j))
#define XB_XGEN(j)  (2304 + 64 * (j))
#define XB_TOP      3328
#define XB_TOPGEN   3392
#define XCD_BAR_WORDS 3456
#define XB_SPIN_CAP (1u << 18)

__device__ __forceinline__ unsigned xb_ld(unsigned* p)              { return __hip_atomic_load(p, __ATOMIC_RELAXED, __HIP_MEMORY_SCOPE_AGENT); }
__device__ __forceinline__ unsigned xb_add(unsigned* p, unsigned v) { return __hip_atomic_fetch_add(p, v, __ATOMIC_RELAXED, __HIP_MEMORY_SCOPE_AGENT); }
__device__ __forceinline__ unsigned xb_xcc_id() { return (unsigned)__builtin_amdgcn_s_getreg((3 << 11) | 20) & 0xFu; }
#define XB_SPIN(cond, bar) do { unsigned _sp = 0; while (cond) { __builtin_amdgcn_s_sleep(1); \
    if ((++_sp & 255u) == 0u) { if (xb_ld(&(bar)[XB_TMO])) break; if (_sp > XB_SPIN_CAP) { atomicAdd(&(bar)[XB_TMO], 1u); break; } } } } while (0)

struct XcdBarrier {
    unsigned* bar; unsigned x;
    volatile LAS unsigned* st;
};

__device__ __forceinline__ XcdBarrier xcd_barrier_post(unsigned* bar, volatile LAS unsigned* st, bool is_t0) {
    XcdBarrier b; b.bar = bar; b.x = xb_xcc_id(); b.st = st;
    if (is_t0) (void)xb_add(&bar[XB_XCNT(b.x)], 1u);
    return b;
}
__device__ __forceinline__ void xcd_barrier_complete(unsigned* bar, unsigned x, unsigned& nloc, unsigned& nx) {
    const unsigned G = gridDim.x * gridDim.y * gridDim.z;
    unsigned sum, cnt, mine, sp = 0u;
    for (;;) {
        sum = 0u; cnt = 0u; mine = 0u;
#pragma unroll
        for (unsigned j = 0; j < 16; ++j) { const unsigned c = xb_ld(&bar[XB_XCNT(j)]); sum += c; cnt += (c > 0u) ? 1u : 0u; mine = (j == x) ? c : mine; }
        if (sum == G) break;
        __builtin_amdgcn_s_sleep(1);
        if ((++sp & 255u) == 0u) { if (xb_ld(&bar[XB_TMO])) break; if (sp > XB_SPIN_CAP) { atomicAdd(&bar[XB_TMO], 1u); break; } }
    }
    nloc = mine > 0u ? mine : 1u; nx = cnt > 0u ? cnt : 1u;
}

__device__ __forceinline__ void xcd_barrier(const XcdBarrier& b, bool is_t0) {
    asm volatile("s_waitcnt vmcnt(0)" ::: "memory");
    __syncthreads();
    if (is_t0) {
        unsigned* bar = b.bar;
        __builtin_amdgcn_s_waitcnt(0);
        unsigned nloc = b.st[0], nx = b.st[1];
        if (nloc == 0u) { xcd_barrier_complete(bar, b.x, nloc, nx); b.st[0] = nloc; b.st[1] = nx; }
        const unsigned old = xb_add(&bar[XB_XSUB(b.x)], 1u);
        const unsigned gen = old / nloc;
        if (old + 1u == (gen + 1u) * nloc) {
            __builtin_amdgcn_fence(__ATOMIC_RELEASE, "agent");
            asm volatile("s_waitcnt vmcnt(0)" ::: "memory");
            const unsigned og = xb_add(&bar[XB_TOP], 1u);
            const unsigned tg = og / nx;
            if (og + 1u == (tg + 1u) * nx) xb_add(&bar[XB_TOPGEN], 1u);
            else XB_SPIN(xb_ld(&bar[XB_TOPGEN]) == tg, bar);
            __builtin_amdgcn_fence(__ATOMIC_ACQUIRE, "agent");
            asm volatile("s_waitcnt vmcnt(0)" ::: "memory");
        } else {
            XB_SPIN(xb_ld(&bar[XB_TOPGEN]) == gen, bar);
            __builtin_amdgcn_fence(__ATOMIC_ACQUIRE, "agent");
            asm volatile("s_waitcnt vmcnt(0)" ::: "memory");
        }
    }
    __syncthreads();
}

__global__ void __launch_bounds__(512, 2) fwd_mega(Args a) {
    extern __shared__ __attribute__((aligned(16))) unsigned char lds[];
    cg::grid_group grid = cg::this_grid();
    const int wave_s = __builtin_amdgcn_readfirstlane((int)threadIdx.x >> 6);
    int tid, lane, wave;
    const int lo = a.ph_lo, hi = a.ph_hi, G = gridDim.x, bx = blockIdx.x;
    const bool is_t0 = (wave_s == 0) && (__builtin_amdgcn_mbcnt_hi(~0u, __builtin_amdgcn_mbcnt_lo(~0u, 0u)) == 0u);
    volatile LAS unsigned* bst = (volatile LAS unsigned*)((LAS unsigned char*)lds + 131072 + 512);
    if (is_t0) { bst[0] = 0u; bst[1] = 0u; }
    __syncthreads();
    XcdBarrier xbar; xbar.bar = (unsigned*)(a.ws + WS_BAR); xbar.x = 0; xbar.st = bst;
    unsigned char* ws = a.ws;
    PG8_LAS unsigned char* lds3 = (PG8_LAS unsigned char*)lds;
    bf16_t* XN = (bf16_t*)(ws + WS_XN); bf16_t* Mb = (bf16_t*)(ws + WS_M);
    const bool rs_in_lds = (G == 256);
    const float* RSg = (const float*)(ws + WS_RS); const LAS float* rsl = (const LAS float*)((LAS unsigned char*)lds + LDS_RS_OFF); const int rbase = 4096 * (bx & 7);
#define RS_TO_LDS() do { for (int i_ = tid; i_ < 1024; i_ += 512) ((LAS f32x4*)((LAS unsigned char*)lds + LDS_RS_OFF))[i_] = *(const f32x4*)(RSg + rbase + 4 * i_); __syncthreads(); } while (0)
#define IN(k) (lo <= (k) && (k) < hi)
#define FRESH() do { lane = (int)__builtin_amdgcn_mbcnt_hi(~0u, __builtin_amdgcn_mbcnt_lo(~0u, 0u)); asm volatile("" : "+v"(lane)); tid = wave_s * 64 + lane; wave = wave_s; } while (0)
#define SEAM(k) do { if (IN(k) && IN((k) + 1)) { if ((k) == 0) { grid.sync(); xbar = xcd_barrier_post((unsigned*)(ws + WS_BAR), bst, is_t0); } else { xcd_barrier(xbar, is_t0); if (PROBE_DUP_BAR) xcd_barrier(xbar, is_t0); } } } while (0)
    if (IN(0)) for (int rep_ = 0; rep_ <= ((PROBE_DUP_MASK >> 0) & 1); ++rep_) { if (rep_) __syncthreads(); FRESH(); if (bx == 0) for (int i_ = tid; i_ < XCD_BAR_WORDS; i_ += 512) __hip_atomic_store((unsigned*)(ws + WS_BAR) + i_, 0u, __ATOMIC_RELAXED, __HIP_MEMORY_SCOPE_AGENT); if (bx == 0) for (int i_ = tid; i_ < 64 * 9; i_ += 512) __hip_atomic_store((unsigned*)(ws + WS_CTL2) + i_, 0u, __ATOMIC_RELAXED, __HIP_MEMORY_SCOPE_AGENT); phase0(a, lds, tid, lane, wave); } SEAM(0);
    if (IN(1)) for (int rep_ = 0; rep_ <= ((PROBE_DUP_MASK >> 1) & 1); ++rep_) { if (rep_) __syncthreads(); FRESH(); cumsum_phase(a, lds, tid, lane, wave);
        pg8::Gemm g{XN, (const bf16_t*)(ws + WS_WIN0), T, 2048, 1024}; pg8::StaticOrder S; S.init(T, 2048, G, bx); if (rs_in_lds) { RS_TO_LDS(); EpiQKVU<true> E{(bf16_t*)(ws + WS_QKVU), (unsigned*)(ws + WS_CTL2), RowScale<true>{RSg, rsl, rbase}}; pg8::gemm_phase<EpiQKVU<true>, pg8::StaticOrder, true, true>(lds3, g, S, E, tid); }
        else { EpiQKVU<false> E{(bf16_t*)(ws + WS_QKVU), (unsigned*)(ws + WS_CTL2), RowScale<false>{RSg, rsl, rbase}}; pg8::gemm_phase<EpiQKVU<false>, pg8::StaticOrder, true, true>(lds3, g, S, E, tid); } } SEAM(1);
    if (IN(2)) for (int rep_ = 0; rep_ <= ((PROBE_DUP_MASK >> 2) & 1); ++rep_) { if (rep_) __syncthreads(); FRESH(); pool_phase(a, tid); attn_phase(a, lds, tid, lane, wave); } SEAM(2);
    if (IN(3)) for (int rep_ = 0; rep_ <= ((PROBE_DUP_MASK >> 3) & 1); ++rep_) { if (rep_) __syncthreads(); FRESH(); pg8::Gemm g{(const bf16_t*)(ws + WS_CAT), (const bf16_t*)(ws + WS_WOUT0), T, 1024, 1024}; pg8::StaticOrder S; S.init(T, 1024, G, bx); EpiPlain E{Mb, 1024};
        pg8::gemm_phase<EpiPlain, pg8::StaticOrder, true, true>(lds3, g, S, E, tid); } SEAM(3);
    if (IN(4)) for (int rep_ = 0; rep_ <= ((PROBE_DUP_MASK >> 4) & 1); ++rep_) { if (rep_) __syncthreads(); FRESH(); ew_phase<false, false>(Mb, nullptr, XN, XN, nullptr, a.in[I_MIX_POST], (float*)(ws + WS_RS), lane, wave); } SEAM(4);
    if (IN(5)) for (int rep_ = 0; rep_ <= ((PROBE_DUP_MASK >> 5) & 1); ++rep_) { if (rep_) __syncthreads(); FRESH(); pg8::Gemm g{XN, (const bf16_t*)(ws + WS_WGU0), T, 2 * DFF, 1024}; pg8::StaticOrder S; S.init(T, 2 * DFF, G, bx); if (rs_in_lds) { RS_TO_LDS(); EpiSwiglu<true> E{(bf16_t*)(ws + WS_H), RowScale<true>{RSg, rsl, rbase}}; pg8::gemm_phase<EpiSwiglu<true>, pg8::StaticOrder, true, true>(lds3, g, S, E, tid); }
        else { EpiSwiglu<false> E{(bf16_t*)(ws + WS_H), RowScale<false>{RSg, rsl, rbase}}; pg8::gemm_phase<EpiSwiglu<false>, pg8::StaticOrder, true, true>(lds3, g, S, E, tid); } } SEAM(5);
    if (IN(6)) for (int rep_ = 0; rep_ <= ((PROBE_DUP_MASK >> 6) & 1); ++rep_) { if (rep_) __syncthreads(); FRESH(); pg8::Gemm g{(const bf16_t*)(ws + WS_H), (const bf16_t*)(ws + WS_WD0), T, 1024, DFF}; pg8::StaticOrder S; S.init(T, 1024, G, bx); EpiPlain E{Mb, 1024};
        pg8::gemm_phase<EpiPlain, pg8::StaticOrder, true, true>(lds3, g, S, E, tid); } SEAM(6);
    if (IN(7)) for (int rep_ = 0; rep_ <= ((PROBE_DUP_MASK >> 7) & 1); ++rep_) { if (rep_) __syncthreads(); FRESH(); ew_phase<false, false>(Mb, nullptr, XN, XN, nullptr, a.in[I_FFN_POST], (float*)(ws + WS_RS), lane, wave); } SEAM(7);
    if (IN(8)) for (int rep_ = 0; rep_ <= ((PROBE_DUP_MASK >> 8) & 1); ++rep_) { if (rep_) __syncthreads(); FRESH(); pg8::Gemm g{XN, (const bf16_t*)(ws + WS_WIN1), T, 2048, 1024}; pg8::StaticOrder S; S.init(T, 2048, G, bx); if (rs_in_lds) { RS_TO_LDS(); EpiOddIn<true> E{(bf16_t*)(ws + WS_G), (bf16_t*)(ws + WS_XR), RowScale<true>{RSg, rsl, rbase}}; pg8::gemm_phase<EpiOddIn<true>, pg8::StaticOrder, true, true>(lds3, g, S, E, tid); }
        else { EpiOddIn<false> E{(bf16_t*)(ws + WS_G), (bf16_t*)(ws + WS_XR), RowScale<false>{RSg, rsl, rbase}}; pg8::gemm_phase<EpiOddIn<false>, pg8::StaticOrder, true, true>(lds3, g, S, E, tid); } } SEAM(8);
    if (IN(9)) for (int rep_ = 0; rep_ <= ((PROBE_DUP_MASK >> 9) & 1); ++rep_) { if (rep_) __syncthreads(); FRESH(); conv_phase(a, tid); } SEAM(9);
    if (IN(10)) for (int rep_ = 0; rep_ <= ((PROBE_DUP_MASK >> 10) & 1); ++rep_) { if (rep_) __syncthreads(); FRESH(); int kg = 256; asm volatile("" : "+s"(kg)); pg8::Gemm g{(const bf16_t*)(ws + WS_XC), (const bf16_t*)(ws + WS_WAX), 4 * T, 2048, kg}; GatesOrder S{G, bx};
        EpiGates E{(const bf16_t*)(ws + WS_XC), a.in[I_OD_BA], a.in[I_OD_BX], (const float*)(ws + WS_LU), (bf16_t*)(ws + WS_A32), (bf16_t*)(ws + WS_BV)};
        pg8::gemm_phase<EpiGates, GatesOrder, true, true>(lds3, g, S, E, tid); } SEAM(10);
    if (IN(11)) for (int rep_ = 0; rep_ <= ((PROBE_DUP_MASK >> 11) & 1); ++rep_) { if (rep_) __syncthreads(); FRESH(); scan1_phase(a, tid); } SEAM(11);
    if (IN(12)) for (int rep_ = 0; rep_ <= ((PROBE_DUP_MASK >> 12) & 1); ++rep_) { if (rep_) __syncthreads(); FRESH(); scan2_phase(a, tid); } SEAM(12);
    if (IN(13)) for (int rep_ = 0; rep_ <= ((PROBE_DUP_MASK >> 13) & 1); ++rep_) { if (rep_) __syncthreads(); FRESH(); pg8::Gemm g{(const bf16_t*)(ws + WS_YG), (const bf16_t*)(ws + WS_WOUT1), T, 1024, 1024}; pg8::StaticOrder S; S.init(T, 1024, G, bx); EpiPlain E{Mb, 1024};
        pg8::gemm_phase<EpiPlain, pg8::StaticOrder, true, true>(lds3, g, S, E, tid); } SEAM(13);
    if (IN(14)) for (int rep_ = 0; rep_ <= ((PROBE_DUP_MASK >> 14) & 1); ++rep_) { if (rep_) __syncthreads(); FRESH(); ew_phase<false, false>(Mb, nullptr, XN, XN, nullptr, a.in[I_MIX_POST] + 1024, (float*)(ws + WS_RS), lane, wave); } SEAM(14);
    if (IN(15)) for (int rep_ = 0; rep_ <= ((PROBE_DUP_MASK >> 15) & 1); ++rep_) { if (rep_) __syncthreads(); FRESH(); pg8::Gemm g{XN, (const bf16_t*)(ws + WS_WGU1), T, 2 * DFF, 1024}; pg8::StaticOrder S; S.init(T, 2 * DFF, G, bx); if (rs_in_lds) { RS_TO_LDS(); EpiSwiglu<true> E{(bf16_t*)(ws + WS_H), RowScale<true>{RSg, rsl, rbase}}; pg8::gemm_phase<EpiSwiglu<true>, pg8::StaticOrder, true, true>(lds3, g, S, E, tid); }
        else { EpiSwiglu<false> E{(bf16_t*)(ws + WS_H), RowScale<false>{RSg, rsl, rbase}}; pg8::gemm_phase<EpiSwiglu<false>, pg8::StaticOrder, true, true>(lds3, g, S, E, tid); } } SEAM(15);
    if (IN(16)) for (int rep_ = 0; rep_ <= ((PROBE_DUP_MASK >> 16) & 1); ++rep_) { if (rep_) __syncthreads(); FRESH(); pg8::Gemm g{(const bf16_t*)(ws + WS_H), (const bf16_t*)(ws + WS_WD1), T, 1024, DFF}; pg8::StaticOrder S; S.init(T, 1024, G, bx); EpiPlain E{Mb, 1024};
        pg8::gemm_phase<EpiPlain, pg8::StaticOrder, true, true>(lds3, g, S, E, tid); } SEAM(16);
    if (IN(17)) for (int rep_ = 0; rep_ <= ((PROBE_DUP_MASK >> 17) & 1); ++rep_) { if (rep_) __syncthreads(); FRESH(); ew_phase<false, true>(Mb, nullptr, XN, XN, a.out, a.in[I_FFN_POST] + 1024, nullptr, lane, wave); }
#undef IN
#undef SEAM
}
extern "C" void kernel_launch(void* const* d_in, const int* in_sizes, int n_in, void* d_out, int out_size, void* d_ws, size_t ws_size, hipStream_t stream) {
    static int grid = 0;
    if (grid == 0) {
        if (n_in != 22 || out_size != T * DM || ws_size < WS_END) { fprintf(stderr, "kernel_launch: unexpected problem (n_in %d out %d ws %zu)\n", n_in, out_size, ws_size); grid = -1; return; }
        int dev = 0, cus = 0, per_cu = 0;
        hipGetDevice(&dev); hipDeviceGetAttribute(&cus, hipDeviceAttributeMultiprocessorCount, dev);
        if (hipFuncSetAttribute((const void*)fwd_mega, hipFuncAttributeMaxDynamicSharedMemorySize, LDS_BYTES) != hipSuccess) { fprintf(stderr, "kernel_launch: hipFuncSetAttribute failed\n"); grid = -1; return; }
        if (hipOccupancyMaxActiveBlocksPerMultiprocessor(&per_cu, (const void*)fwd_mega, 512, LDS_BYTES) != hipSuccess || per_cu < 1) { fprintf(stderr, "kernel_launch: occupancy query says %d\n", per_cu); per_cu = 1; }
        (void)hipGetLastError();
        grid = cus * per_cu;
    }
    if (grid < 0) return;
    Args a{};
    for (int i = 0; i < 22; ++i) a.in[i] = (const float*)d_in[i];
    a.out = (float*)d_out; a.ws = (unsigned char*)d_ws;
#if MK_PER_PHASE
    for (int p = 0; p < NPHASE; ++p) { a.ph_lo = p; a.ph_hi = p + 1; hipLaunchKernelGGL(fwd_mega, dim3(grid), dim3(512), LDS_BYTES, stream, a); }
#else
    a.ph_lo = 0; a.ph_hi = NPHASE;
    void* args[] = {&a};
    hipError_t e = hipLaunchCooperativeKernel((const void*)fwd_mega, dim3(grid), dim3(512), args, LDS_BYTES, stream);
    if (e != hipSuccess) fprintf(stderr, "kernel_launch: cooperative launch failed: %s (grid %d)\n", hipGetErrorString(e), grid);
#endif
}
```

```cpp
#include <hip/hip_runtime.h>
#include <hip/hip_cooperative_groups.h>
#include <cstdio>
#include <cstdint>
#include <cmath>
namespace cg = cooperative_groups;
namespace pg8 {
#define PG8_LAS __attribute__((address_space(3)))
typedef unsigned short bf16_t;
typedef short bf16x8 __attribute__((ext_vector_type(8)));
typedef float f32x4 __attribute__((ext_vector_type(4)));
typedef unsigned u32x4 __attribute__((ext_vector_type(4)));
constexpr int BM = 256, BK = 64, HALF = 128, HTB = HALF * BK * 2  , STAGE_BYTES = 8 * HTB, NXCD = 8, WGM = 8;

__host__ __device__ __forceinline__ int lds_byte(int r, int c) { const int st = (r >> 4) * 2 + (c >> 5), rr = r & 15, cc = c & 31, ob = rr * 64 + cc * 2; return st * 1024 + (ob ^ (((ob >> 9) & 1) << 5)); }
__host__ __device__ __forceinline__ void stage_rc(int b, int& R, int& C) { const int st = b / 1024, sb = b % 1024, swz = sb ^ (((sb >> 9) & 1) << 5); R = (st >> 1) * 16 + swz / 64; C = (st & 1) * 32 + (swz % 64) / 2; }
__host__ __device__ __forceinline__ int perm32(int rho) { const int n = rho >> 4, i = rho & 15; return 8 * (i >> 2) + 4 * n + (i & 3); }

struct Unit { int pm, pn; };
struct Gemm { const bf16_t* A; const bf16_t* Bt; int M, N, K; };

struct StaticOrder {
    int nM, nN, nwg, G, c;
    __host__ __device__ void init(int M, int N, int G_, int c_) { nM = M / BM; nN = N / BM; nwg = nM * nN; G = G_; c = c_; }
    __host__ __device__ bool next(int i, Unit& u) const {
        const long L = (long)i * G + c; if (L >= nwg) return false;
        int wgid = (int)L; { const int q = nwg / NXCD, r = nwg % NXCD, xcd = wgid % NXCD, off = wgid / NXCD; wgid = (xcd < r ? xcd * (q + 1) : r * (q + 1) + (xcd - r) * q) + off; }
        const int nig = WGM * nN, gid = wgid / nig, fm = gid * WGM, gsz = (nM - fm) < WGM ? (nM - fm) : WGM;
        u.pm = fm + ((wgid % nig) % gsz); u.pn = (wgid % nig) / gsz; return true;
    }
    __device__ __forceinline__ void a_ready(const Unit&) const {}
    __device__ __forceinline__ void done(const Unit&) const {}
};

__device__ __forceinline__ unsigned cvt_pk_bf16(float lo, float hi) { unsigned r; asm volatile("v_cvt_pk_bf16_f32 %0, %1, %2" : "=v"(r) : "v"(lo), "v"(hi)); return r; }
typedef float f32x2 __attribute__((ext_vector_type(2)));
template <class Epi, class Sched, bool ALIGN_EPI = false, bool SP2 = false>
__device__ __forceinline__ void gemm_phase(PG8_LAS unsigned char* lds, const Gemm g, const Sched& S, const Epi& E, int tid_in) {
    int tid_ = tid_in; asm volatile("" : "+v"(tid_)); const int tid = tid_, wid = __builtin_amdgcn_readfirstlane(tid >> 6), lane = tid & 63, wr = wid >> 2, wc = wid & 3, fr = lane & 15, fq = lane >> 4;
    const int K = g.K, nt = K / BK;
    unsigned voffA[2], voffB[2];
#pragma unroll
    for (int i = 0; i < 2; ++i) { int R, C; stage_rc(tid * 16 + i * 8192, R, C); const int Rb = Epi::PERM ? ((R & ~31) + perm32(R & 31)) : R;
        voffA[i] = (unsigned)(R * K + C) * 2u; voffB[i] = (unsigned)(Rb * K + C) * 2u; }
    const size_t kstep = (size_t)(BK * 2);
    const size_t hstep = (size_t)HALF * K * 2;
    const size_t tstep = 2 * hstep;
    const unsigned ldsw = (unsigned)wid * 1024u;
    const int aoff = lds_byte(wr * 64 + fr, fq * 8), boff = lds_byte(wc * 32 + fr, fq * 8);
#define PG8_SA(b, h) (((b) * 2 + (h)) * HTB)
#define PG8_SB(b, h) ((4 + (b) * 2 + (h)) * HTB)
#define PG8_STAGE(bufoff, gbase, voff) do { _Pragma("unroll") for (int _i = 0; _i < 2; ++_i) \
        __builtin_amdgcn_global_load_lds((const unsigned*)((const char*)(gbase) + (voff)[_i]), (PG8_LAS unsigned*)(lds + (bufoff) + ldsw + _i * 8192), 16, 0, 0); } while (0)
#define PG8_LDA(dst, b, h) do { _Pragma("unroll") for (int m = 0; m < 4; ++m) _Pragma("unroll") for (int k = 0; k < 2; ++k) dst[m][k] = *(const PG8_LAS bf16x8*)(lds + PG8_SA(b, h) + aoff + m * 2048 + k * 1024); } while (0)
#define PG8_LDB(dst, b, h) do { _Pragma("unroll") for (int n = 0; n < 2; ++n) _Pragma("unroll") for (int k = 0; k < 2; ++k) dst[n][k] = *(const PG8_LAS bf16x8*)(lds + PG8_SB(b, h) + boff + n * 2048 + k * 1024); } while (0)
#define PG8_MMA(ai, bj, At, Bt) do { __builtin_amdgcn_s_setprio(1); _Pragma("unroll") for (int m = 0; m < 4; ++m) _Pragma("unroll") for (int n = 0; n < 2; ++n) _Pragma("unroll") for (int k = 0; k < 2; ++k) \
        acc[ai][bj][m][n] = __builtin_amdgcn_mfma_f32_16x16x32_bf16(Bt[n][k], At[m][k], acc[ai][bj][m][n], 0, 0, 0); __builtin_amdgcn_s_setprio(0); } while (0)
#define PG8_WAIT_V(n) asm volatile("s_waitcnt vmcnt(" #n ")" ::: "memory")
#define PG8_WAIT_L(n) asm volatile("s_waitcnt lgkmcnt(" #n ")" ::: "memory")
#define PG8_BAR __builtin_amdgcn_s_barrier()
#define PG8_SCHED __builtin_amdgcn_sched_barrier(0)
    Unit cur, nxt; int ui = 0;
    if (!S.next(0, cur)) return;
    f32x4 acc[2][2][4][2];
#pragma unroll
    for (int a = 0; a < 2; ++a)
#pragma unroll
        for (int b = 0; b < 2; ++b)
#pragma unroll
            for (int m = 0; m < 4; ++m)
#pragma unroll
                for (int n = 0; n < 2; ++n) acc[a][b][m][n] = (f32x4){0.f, 0.f, 0.f, 0.f};
    bf16x8 At[4][2], B0[2][2], B1[2][2];
    const char* cA = (const char*)g.A + (size_t)cur.pm * tstep; const char* cB = (const char*)g.Bt + (size_t)cur.pn * tstep;
    S.a_ready(cur);
    if constexpr (SP2) {
        PG8_STAGE(PG8_SB(0, 0), cB, voffB); PG8_STAGE(PG8_SB(0, 1), cB + hstep, voffB); PG8_STAGE(PG8_SA(0, 0), cA, voffA); PG8_STAGE(PG8_SA(0, 1), cA + hstep, voffA);
        if (wr == 1) PG8_BAR;
        PG8_WAIT_V(2); PG8_BAR;
        PG8_STAGE(PG8_SB(1, 0), cB + kstep, voffB); PG8_STAGE(PG8_SA(1, 0), cA + kstep, voffA); PG8_STAGE(PG8_SB(1, 1), cB + hstep + kstep, voffB);
        PG8_WAIT_V(6); PG8_BAR;
    } else {
        PG8_STAGE(PG8_SB(0, 0), cB, voffB); PG8_STAGE(PG8_SA(0, 0), cA, voffA); PG8_STAGE(PG8_SB(0, 1), cB + hstep, voffB); PG8_STAGE(PG8_SA(0, 1), cA + hstep, voffA);
        if (wr == 1) PG8_BAR;
        PG8_WAIT_V(4); PG8_BAR;
        PG8_STAGE(PG8_SB(1, 0), cB + kstep, voffB); PG8_STAGE(PG8_SA(1, 0), cA + kstep, voffA); PG8_STAGE(PG8_SB(1, 1), cB + hstep + kstep, voffB);
        PG8_WAIT_V(6); PG8_BAR;
    }
    for (;;) {
        const bool has_next = S.next(ui + 1, nxt);
        const char* nA = has_next ? (const char*)g.A + (size_t)nxt.pm * tstep : cA; const char* nB = has_next ? (const char*)g.Bt + (size_t)nxt.pn * tstep : cB;
        for (int t = 0; t < nt; t += 2) {
            const bool last = (t == nt - 2);
            const char* a1 = cA + (size_t)(t + 1) * kstep;
            const char* a2 = last ? nA : cA + (size_t)(t + 2) * kstep; const char* b2 = last ? nB : cB + (size_t)(t + 2) * kstep;
            const char* a3 = a2 + kstep; const char* b3 = b2 + kstep;
            if (last && has_next) S.a_ready(nxt);
            if constexpr (SP2) {
            PG8_LDB(B0, 0, 0); PG8_LDB(B1, 0, 1); PG8_SCHED; PG8_LDA(At, 0, 0); PG8_STAGE(PG8_SA(1, 1), a1 + hstep, voffA);
            PG8_WAIT_V(8); PG8_WAIT_L(0); PG8_BAR; PG8_MMA(0, 0, At, B0); PG8_MMA(0, 1, At, B1); PG8_BAR; PG8_SCHED;
            PG8_LDA(At, 0, 1); PG8_STAGE(PG8_SB(0, 0), b2, voffB); PG8_STAGE(PG8_SB(0, 1), b2 + hstep, voffB); PG8_STAGE(PG8_SA(0, 0), a2, voffA);
            PG8_WAIT_V(8); PG8_WAIT_L(0); PG8_BAR; PG8_MMA(1, 0, At, B0); PG8_MMA(1, 1, At, B1); PG8_BAR; PG8_SCHED;
            PG8_LDB(B0, 1, 0); PG8_LDB(B1, 1, 1); PG8_SCHED; PG8_LDA(At, 1, 0); PG8_STAGE(PG8_SA(0, 1), a2 + hstep, voffA);
            PG8_WAIT_V(8); PG8_WAIT_L(0); PG8_BAR; PG8_MMA(0, 0, At, B0); PG8_MMA(0, 1, At, B1); PG8_BAR; PG8_SCHED;
            PG8_LDA(At, 1, 1); PG8_STAGE(PG8_SB(1, 0), b3, voffB); PG8_STAGE(PG8_SB(1, 1), b3 + hstep, voffB); PG8_STAGE(PG8_SA(1, 0), a3, voffA);
            PG8_WAIT_V(8); PG8_WAIT_L(0); PG8_BAR; PG8_MMA(1, 0, At, B0); PG8_MMA(1, 1, At, B1); PG8_BAR; PG8_SCHED;
            } else {
            PG8_LDB(B0, 0, 0); PG8_SCHED; PG8_LDA(At, 0, 0); PG8_STAGE(PG8_SA(1, 1), a1 + hstep, voffA);
            PG8_WAIT_L(8); PG8_BAR; PG8_WAIT_L(0); PG8_MMA(0, 0, At, B0); PG8_BAR; PG8_SCHED;
            PG8_LDB(B1, 0, 1); PG8_STAGE(PG8_SB(0, 0), b2, voffB);
            PG8_BAR; PG8_WAIT_L(0); PG8_MMA(0, 1, At, B1); PG8_BAR;
            PG8_LDA(At, 0, 1); PG8_STAGE(PG8_SA(0, 0), a2, voffA);
            PG8_BAR; PG8_WAIT_L(0); PG8_MMA(1, 0, At, B0); PG8_BAR; PG8_SCHED;
            PG8_STAGE(PG8_SB(0, 1), b2 + hstep, voffB);
            PG8_WAIT_V(6); PG8_BAR; PG8_MMA(1, 1, At, B1); PG8_BAR;
            PG8_LDB(B0, 1, 0); PG8_SCHED; PG8_LDA(At, 1, 0); PG8_STAGE(PG8_SA(0, 1), a2 + hstep, voffA);
            PG8_WAIT_L(8); PG8_BAR; PG8_WAIT_L(0); PG8_MMA(0, 0, At, B0); PG8_BAR; PG8_SCHED;
            PG8_LDB(B1, 1, 1); PG8_STAGE(PG8_SB(1, 0), b3, voffB);
            PG8_BAR; PG8_WAIT_L(0); PG8_MMA(0, 1, At, B1); PG8_BAR;
            PG8_LDA(At, 1, 1); PG8_STAGE(PG8_SA(1, 0), a3, voffA);
            PG8_BAR; PG8_WAIT_L(0); PG8_MMA(1, 0, At, B0); PG8_BAR; PG8_SCHED;
            PG8_STAGE(PG8_SB(1, 1), b3 + hstep, voffB);
            PG8_WAIT_V(6); PG8_BAR; PG8_MMA(1, 1, At, B1); PG8_BAR;
            }
        }
        if constexpr (ALIGN_EPI) { if (wr == 0) PG8_BAR; }
        if constexpr (!Epi::AFTER_DRAIN) { E(acc, cur, wr, wc, fr, fq); S.done(cur); }
        if (!has_next) break;
#pragma unroll
        for (int a = 0; a < 2; ++a)
#pragma unroll
            for (int b = 0; b < 2; ++b)
#pragma unroll
                for (int m = 0; m < 4; ++m)
#pragma unroll
                    for (int n = 0; n < 2; ++n) acc[a][b][m][n] = (f32x4){0.f, 0.f, 0.f, 0.f};
        cur = nxt; cA = nA; cB = nB; ++ui;
        if constexpr (ALIGN_EPI) { if (wr == 1) PG8_BAR; }
    }
    PG8_WAIT_V(0);
    if constexpr (!ALIGN_EPI) { if (wr == 0) PG8_BAR; }
    PG8_BAR;
    if constexpr (Epi::AFTER_DRAIN) { E.fused(acc, cur, wr, wc, fr, fq, lds, wid, lane); S.done(cur); }
#undef PG8_SA
#undef PG8_SB
#undef PG8_STAGE
#undef PG8_LDA
#undef PG8_LDB
#undef PG8_MMA
#undef PG8_WAIT_V
#undef PG8_WAIT_L
#undef PG8_BAR
#undef PG8_SCHED
}
}
#ifndef PROBE_DUP_EPI
#define PROBE_DUP_EPI 0
#endif
#ifndef PROBE_EW
#define PROBE_EW 0
#endif
#ifndef PROBE_DUP_MASK
#define PROBE_DUP_MASK 0
#endif
#ifndef PROBE_DUP_BAR
#define PROBE_DUP_BAR 0
#endif
#ifndef MK_PER_PHASE
#define MK_PER_PHASE 0
#endif
using pg8::bf16_t; using pg8::bf16x8; using pg8::f32x4; using pg8::u32x4; using pg8::Unit;
typedef float f32x16 __attribute__((ext_vector_type(16)));
typedef float f32x2 __attribute__((ext_vector_type(2)));
typedef unsigned u32x2 __attribute__((ext_vector_type(2)));
#define LAS __attribute__((address_space(3)))

constexpr int BATCH = 4, SEQ = 8192, DM = 1024, T = BATCH * SEQ;
constexpr int NHEAD = 8, HD = 64, EV_IN = 2056, DFF = 2816;
constexpr float RMS_EPS = 1e-6f;
constexpr float LOG2E = 1.4426950408889634f;
constexpr float QSCALE = 0.125f * LOG2E;
constexpr int NPHASE = 18;
constexpr int LDS_BYTES = 163840;
constexpr int LDS_RS_OFF = 131072 + 2048;

constexpr size_t MiB = 1u << 20;
constexpr size_t WS_WIN0 = 0, WS_WOUT0 = 4 * MiB, WS_WGU0 = 6 * MiB, WS_WD0 = 17 * MiB, WS_WIN1 = 23 * MiB, WS_WAX = 27 * MiB, WS_WOUT1 = 28 * MiB,
                 WS_WGU1 = 30 * MiB, WS_WD1 = 41 * MiB, WS_LOGF = 47 * MiB, WS_C2 = 48 * MiB, WS_LU = 49 * MiB, WS_SP = 50 * MiB, WS_SH = 51 * MiB, WS_BAR = 52 * MiB, WS_KC = 53 * MiB, WS_CTL2 = 55 * MiB, WS_RS = 55 * MiB + 512 * 1024;
constexpr size_t WS_XN = 56 * MiB, WS_M = 120 * MiB, WS_S = 184 * MiB;
constexpr size_t WS_QKVU = WS_S, WS_CAT = WS_S + 128 * MiB, WS_H = WS_S;
constexpr size_t WS_G = WS_S, WS_XC = WS_S + 64 * MiB, WS_BV = WS_S + 128 * MiB, WS_XR = WS_S + 192 * MiB, WS_A32 = WS_S + 192 * MiB, WS_YG = WS_XC;
constexpr size_t WS_END = WS_S + 320 * MiB;

__device__ __forceinline__ unsigned pk2(float lo, float hi) { return pg8::cvt_pk_bf16(lo, hi); }
__device__ __forceinline__ float bf_lo(unsigned w) { return __uint_as_float(w << 16); }
__device__ __forceinline__ float bf_hi(unsigned w) { return __uint_as_float(w & 0xffff0000u); }
__device__ __forceinline__ float wave_sum(float v) {
#define WS_DPP(x, ctrl, rmask) __builtin_bit_cast(float, __builtin_amdgcn_update_dpp(0, __builtin_bit_cast(int, (x)), (ctrl), (rmask), 0xF, false))
    v += WS_DPP(v, 0x111, 0xF);
    v += WS_DPP(v, 0x112, 0xF);
    v += WS_DPP(v, 0x114, 0xF);
    v += WS_DPP(v, 0x118, 0xF);
    v += WS_DPP(v, 0x142, 0xA);
    v += WS_DPP(v, 0x143, 0xC);
#undef WS_DPP
    return __builtin_bit_cast(float, __builtin_amdgcn_readlane(__builtin_bit_cast(int, v), 63));
}
__device__ __forceinline__ float fast_sigmoid(float x) { return __builtin_amdgcn_rcpf(1.f + __expf(-x)); }
__device__ __forceinline__ float softplus_f(float z) { return fmaxf(z, 0.f) + log1pf(__expf(-fabsf(z))); }
__device__ __forceinline__ float gelu_tanh(float x) { const float u = 0.7978845608028654f * (x + 0.044715f * x * x * x); return x * fast_sigmoid(2.f * u); }

struct Args { const float* in[22]; float* out; unsigned char* ws; int ph_lo, ph_hi; };
enum { I_X = 0, I_MIX_PRE, I_MIX_POST, I_FFN_PRE, I_FFN_POST, I_WGATE, I_WUP, I_WDOWN, I_EV_WIN, I_EV_BF, I_EV_POOLW, I_EV_POOLS, I_EV_WOUT,
       I_OD_WIN, I_OD_CONVW, I_OD_CONVB, I_OD_WA, I_OD_BA, I_OD_WX, I_OD_BX, I_OD_LAM, I_OD_WOUT };

template <bool RSL> struct RowScale {
    const float* RS; const LAS float* rsl; int rbase;
    __device__ __forceinline__ float operator()(int row) const { if (RSL) return rsl[row - rbase]; else return RS[row]; }
};
template <bool RSL> struct EpiQKVU {
    static constexpr bool PERM = true, AFTER_DRAIN = false;
    bf16_t* O; unsigned* kmax; RowScale<RSL> RS;
    __device__ __forceinline__ void operator()(const f32x4 (&acc)[2][2][4][2], const Unit& u, int wr, int wc, int fr, int fq) const {
        const int seg = u.pn >> 1; const float sc0 = seg == 0 ? QSCALE : 1.f;
        bf16_t* base = O + (size_t)seg * T * 512 + (u.pn & 1) * 256 + wc * 32 + 8 * fq;
        const int row0 = u.pm * 256 + wr * 64 + fr;
#pragma unroll
        for (int ai = 0; ai < 2; ++ai)
#pragma unroll
            for (int m = 0; m < 4; ++m) { bf16_t* rowp = base + (size_t)(row0 + ai * 128 + m * 16) * 512; const float sc = sc0 * RS(row0 + ai * 128 + m * 16);
#pragma unroll
                for (int bj = 0; bj < 2; ++bj) { const f32x4 v0 = acc[ai][bj][m][0] * sc, v1 = acc[ai][bj][m][1] * sc;
                    u32x4 w; w.x = pk2(v0[0], v0[1]); w.y = pk2(v0[2], v0[3]); w.z = pk2(v1[0], v1[1]); w.w = pk2(v1[2], v1[3]);
                    *(u32x4*)(rowp + bj * 128) = w; } }
        if (seg == 1) {
            float mx[2] = {0.f, 0.f};
#pragma unroll
            for (int bj = 0; bj < 2; ++bj)
#pragma unroll
                for (int ai = 0; ai < 2; ++ai)
#pragma unroll
                    for (int mm = 0; mm < 4; ++mm) { const float rs = RS(row0 + ai * 128 + mm * 16); float s = 0.f;
#pragma unroll
                        for (int n = 0; n < 2; ++n)
#pragma unroll
                            for (int i = 0; i < 4; ++i) { const float v = acc[ai][bj][mm][n][i] * rs; s += v * v; }
                        s += __shfl_xor(s, 16); s += __shfl_xor(s, 32);
                        mx[bj] = fmaxf(mx[bj], s); }
#pragma unroll
            for (int o = 1; o < 16; o <<= 1) { mx[0] = fmaxf(mx[0], __shfl_xor(mx[0], o)); mx[1] = fmaxf(mx[1], __shfl_xor(mx[1], o)); }
            if (fr == 0 && fq == 0) { unsigned* kp = kmax + (u.pm >> 5) * 8 + (u.pn & 1) * 4 + (wc >> 1);
                atomicMax(kp, __float_as_uint(mx[0])); atomicMax(kp + 2, __float_as_uint(mx[1])); }
        }
    }
};
struct EpiPlain {
    static constexpr bool PERM = true, AFTER_DRAIN = false;
    bf16_t* O; int ldc;
    __device__ __forceinline__ void operator()(const f32x4 (&acc)[2][2][4][2], const Unit& u, int wr, int wc, int fr, int fq) const {
        bf16_t* base = O + u.pn * 256 + wc * 32 + 8 * fq; const int row0 = u.pm * 256 + wr * 64 + fr;
#pragma unroll
        for (int ai = 0; ai < 2; ++ai)
#pragma unroll
            for (int m = 0; m < 4; ++m) { bf16_t* rowp = base + (size_t)(row0 + ai * 128 + m * 16) * ldc;
#pragma unroll
                for (int bj = 0; bj < 2; ++bj) { const f32x4 v0 = acc[ai][bj][m][0], v1 = acc[ai][bj][m][1];
                    u32x4 w; w.x = pk2(v0[0], v0[1]); w.y = pk2(v0[2], v0[3]); w.z = pk2(v1[0], v1[1]); w.w = pk2(v1[2], v1[3]);
                    *(u32x4*)(rowp + bj * 128) = w; } }
    }
};
template <bool RSL> struct EpiSwiglu {
    static constexpr bool PERM = true, AFTER_DRAIN = false;
    bf16_t* H; RowScale<RSL> RS;
    __device__ __forceinline__ void operator()(const f32x4 (&acc)[2][2][4][2], const Unit& u, int wr, int wc, int fr, int fq) const {
        bf16_t* base = H + u.pn * 128 + wc * 32 + 8 * fq; const int row0 = u.pm * 256 + wr * 64 + fr;
        for (int rep_e = 0; rep_e <= PROBE_DUP_EPI; ++rep_e) { asm volatile("" ::: "memory");
#pragma unroll
        for (int ai = 0; ai < 2; ++ai)
#pragma unroll
            for (int m = 0; m < 4; ++m) { bf16_t* rowp = base + (size_t)(row0 + ai * 128 + m * 16) * DFF; const float rs = RS(row0 + ai * 128 + m * 16);
                float o[8];
#pragma unroll
                for (int n = 0; n < 2; ++n)
#pragma unroll
                    for (int i = 0; i < 4; ++i) { const float g = acc[ai][0][m][n][i] * rs, up = acc[ai][1][m][n][i] * rs; o[n * 4 + i] = g * fast_sigmoid(g) * up; }
                u32x4 w; w.x = pk2(o[0], o[1]); w.y = pk2(o[2], o[3]); w.z = pk2(o[4], o[5]); w.w = pk2(o[6], o[7]);
                *(u32x4*)rowp = w; }
        }
    }
};
template <bool RSL> struct EpiOddIn {
    static constexpr bool PERM = true, AFTER_DRAIN = false;
    bf16_t* G; bf16_t* XR; RowScale<RSL> RS;
    __device__ __forceinline__ void operator()(const f32x4 (&acc)[2][2][4][2], const Unit& u, int wr, int wc, int fr, int fq) const {
        const bool isg = u.pn < 4;
        bf16_t* base = (isg ? G : XR) + (u.pn & 3) * 256 + wc * 32 + 8 * fq; const int row0 = u.pm * 256 + wr * 64 + fr;
#pragma unroll
        for (int ai = 0; ai < 2; ++ai)
#pragma unroll
            for (int m = 0; m < 4; ++m) { bf16_t* rowp = base + (size_t)(row0 + ai * 128 + m * 16) * 1024; const float rs = RS(row0 + ai * 128 + m * 16);
#pragma unroll
                for (int bj = 0; bj < 2; ++bj) { f32x4 v0 = acc[ai][bj][m][0] * rs, v1 = acc[ai][bj][m][1] * rs;
                    if (isg) {
#pragma unroll
                        for (int i = 0; i < 4; ++i) { v0[i] = gelu_tanh(v0[i]); v1[i] = gelu_tanh(v1[i]); } }
                    u32x4 w; w.x = pk2(v0[0], v0[1]); w.y = pk2(v0[2], v0[3]); w.z = pk2(v1[0], v1[1]); w.w = pk2(v1[2], v1[3]);
                    *(u32x4*)(rowp + bj * 128) = w; } }
    }
};
struct EpiGates {
    static constexpr bool PERM = true, AFTER_DRAIN = false;
    const bf16_t* XC; const float* b_a; const float* b_x; const float* LU; bf16_t* LA; bf16_t* BV;
    __device__ __forceinline__ void operator()(const f32x4 (&acc)[2][2][4][2], const Unit& u, int wr, int wc, int fr, int fq) const {
        asm volatile("" : "+v"(fr), "+v"(fq));
        const int h = u.pm >> 7, j = u.pn & 1, cl = j * 128 + wc * 32 + 8 * fq, c = h * 256 + cl;
        const int t0 = (u.pm & 127) * 256 + wr * 64 + fr;
        f32x4 ba[2], bx[2], lu[2]; u32x4 xw[2][4];
#pragma unroll
        for (int n = 0; n < 2; ++n) { ba[n] = *(const f32x4*)(b_a + c + 4 * n); bx[n] = *(const f32x4*)(b_x + c + 4 * n); lu[n] = *(const f32x4*)(LU + c + 4 * n); }
#pragma unroll
        for (int ai = 0; ai < 2; ++ai)
#pragma unroll
            for (int m = 0; m < 4; ++m) xw[ai][m] = *(const u32x4*)(XC + ((size_t)h * T + t0 + ai * 128 + m * 16) * 256 + cl);
#pragma unroll
        for (int ai = 0; ai < 2; ++ai)
#pragma unroll
            for (int m = 0; m < 4; ++m) { const int t = t0 + ai * 128 + m * 16; const u32x4 x = xw[ai][m];
                const float xc[8] = {bf_lo(x.x), bf_hi(x.x), bf_lo(x.y), bf_hi(x.y), bf_lo(x.z), bf_hi(x.z), bf_lo(x.w), bf_hi(x.w)};
                float lv[8], x2v[8], gx[8], bv[8];
#pragma unroll
                for (int i = 0; i < 8; ++i) { const int n = i >> 2, e = i & 3; const float rp = acc[ai][0][m][n][e] + ba[n][e], ip = acc[ai][1][m][n][e] + bx[n][e];
                    const float r = fast_sigmoid(rp), ig = fast_sigmoid(ip); const float la = r * lu[n][e];
                    lv[i] = la * LOG2E; x2v[i] = 2.f * la; gx[i] = ig * xc[i]; }
                bool bigl = false;
#pragma unroll
                for (int i = 0; i < 8; ++i) bigl |= (x2v[i] <= -0.25f);
                const bool big = __any(bigl);
#pragma unroll
                for (int i = 0; i < 8; ++i) { const float x2 = x2v[i];
                    float om = -x2 * (1.f + x2 * (0.5f + x2 * (0.16666667f + x2 * (0.041666668f + x2 * (0.008333334f + x2 * 0.0013888889f)))));
                    if (big) { const float dr = 1.f - __expf(x2); om = x2 > -0.25f ? om : dr; }
                    bv[i] = __builtin_amdgcn_sqrtf(fmaxf(om, 0.f)) * gx[i]; }
                u32x4 lw; lw.x = pk2(lv[0], lv[1]); lw.y = pk2(lv[2], lv[3]); lw.z = pk2(lv[4], lv[5]); lw.w = pk2(lv[6], lv[7]);
                u32x4 w; w.x = pk2(bv[0], bv[1]); w.y = pk2(bv[2], bv[3]); w.z = pk2(bv[4], bv[5]); w.w = pk2(bv[6], bv[7]);
                *(u32x4*)(LA + (size_t)t * 1024 + c) = lw; *(u32x4*)(BV + (size_t)t * 1024 + c) = w; }
    }
};
struct GatesOrder {
    int G, c;
    __device__ bool next(int i, Unit& u) const { const long L = (long)i * G + c; if (L >= 1024) return false; const int l = (int)L; u.pm = l >> 1; u.pn = 2 * (u.pm >> 7) + (l & 1); return true; }
    __device__ __forceinline__ void a_ready(const Unit&) const {}
    __device__ __forceinline__ void done(const Unit&) const {}
};
__device__ __forceinline__ void tr_item(const float* __restrict__ W, int ld, int k0, int c0, bf16_t* __restrict__ WT, int Kd, int drow0, LAS float* scr, int lane, const float* __restrict__ gk = nullptr) {
    const int r8 = lane >> 3, ch = lane & 7;
    f32x4 v[8];
#pragma unroll
    for (int i = 0; i < 8; ++i) v[i] = __builtin_nontemporal_load((const f32x4*)(W + (size_t)(k0 + r8 + 8 * i) * ld + c0 + 4 * ch));
    if (gk) {
#pragma unroll
        for (int i = 0; i < 8; ++i) v[i] = v[i] * gk[k0 + r8 + 8 * i]; }
#pragma unroll
    for (int i = 0; i < 8; ++i) { LAS float* d = scr + (r8 + 8 * i) * 33 + 4 * ch; d[0] = v[i][0]; d[1] = v[i][1]; d[2] = v[i][2]; d[3] = v[i][3]; }
    asm volatile("s_waitcnt lgkmcnt(0)" ::: "memory");
    const int c = lane & 7;
#pragma unroll
    for (int j = 0; j < 4; ++j) { const int n = (lane >> 3) + 8 * j; const LAS float* s = scr + (8 * c) * 33 + n;
        u32x4 o; o.x = pk2(s[0 * 33], s[1 * 33]); o.y = pk2(s[2 * 33], s[3 * 33]); o.z = pk2(s[4 * 33], s[5 * 33]); o.w = pk2(s[6 * 33], s[7 * 33]);
        *(u32x4*)(WT + (size_t)(drow0 + n) * Kd + k0 + 8 * c) = o; }
    asm volatile("s_waitcnt lgkmcnt(0)" ::: "memory");
}
__device__ __forceinline__ void phase0(const Args& a, unsigned char* lds, int tid, int lane, int wave) {
    unsigned char* ws = a.ws;
    LAS float* scr = (LAS float*)lds + wave * 4096;
    const int gw = blockIdx.x * 8 + wave, NGW = gridDim.x * 8;
    constexpr int NITEMS = 768 + 512 + 5632 + 2816 + 1024 + 256 + 512;
    for (int it = gw; it < NITEMS; it += NGW) {
        int r = it;
        if (r < 768) { const int kb = r / 48, nb = r % 48; tr_item(a.in[I_EV_WIN], EV_IN, 64 * kb, 32 * nb, (bf16_t*)(ws + WS_WIN0), 1024, 32 * nb, scr, lane, a.in[I_MIX_PRE]); continue; } r -= 768;
        if (r < 512) { const int kb = r / 32, nb = r % 32; tr_item(a.in[I_EV_WOUT], 1024, 64 * kb, 32 * nb, (bf16_t*)(ws + WS_WOUT0), 1024, 32 * nb, scr, lane); continue; } r -= 512;
        if (r < 5632) { const int which = r / 1408; r %= 1408; const int l = which >> 1, up = which & 1, kb = r / 88, nb = r % 88, c0 = 32 * nb;
            const float* src = (up ? a.in[I_WUP] : a.in[I_WGATE]) + (size_t)l * 1024 * DFF; bf16_t* dst = (bf16_t*)(ws + (l ? WS_WGU1 : WS_WGU0));
            tr_item(src, DFF, 64 * kb, c0, dst, 1024, 256 * (c0 >> 7) + 128 * up + (c0 & 127), scr, lane, a.in[I_FFN_PRE] + l * 1024); continue; } r -= 5632;
        if (r < 2816) { const int l = r / 1408; r %= 1408; const int kb = r / 32, nb = r % 32;
            tr_item(a.in[I_WDOWN] + (size_t)l * DFF * 1024, 1024, 64 * kb, 32 * nb, (bf16_t*)(ws + (l ? WS_WD1 : WS_WD0)), DFF, 32 * nb, scr, lane); continue; } r -= 2816;
        if (r < 1024) { const int kb = r / 64, nb = r % 64; tr_item(a.in[I_OD_WIN], 2048, 64 * kb, 32 * nb, (bf16_t*)(ws + WS_WIN1), 1024, 32 * nb, scr, lane, a.in[I_MIX_PRE] + 1024); continue; } r -= 1024;
        if (r < 256) { const int which = r / 128; r %= 128; const int h = r / 32; r %= 32; const int kb = r / 8, nb = r % 8, c0 = 32 * nb;
            const float* src = (which ? a.in[I_OD_WX] : a.in[I_OD_WA]) + (size_t)h * 65536;
            tr_item(src, 256, 64 * kb, c0, (bf16_t*)(ws + WS_WAX), 256, 512 * h + 256 * (c0 >> 7) + 128 * which + (c0 & 127), scr, lane); continue; } r -= 256;
        { const int kb = r / 32, nb = r % 32; tr_item(a.in[I_OD_WOUT], 1024, 64 * kb, 32 * nb, (bf16_t*)(ws + WS_WOUT1), 1024, 32 * nb, scr, lane); }
    }
    for (int u = blockIdx.x; u < 256; u += gridDim.x) {
        const int g = u >> 6, k0 = (u & 63) * 16;
        float* As = (float*)lds; float* Wp = As + 16 * 128;
        __syncthreads();
        { const int row = tid >> 5, c4 = tid & 31; ((f32x4*)As)[tid] = *(const f32x4*)(a.in[I_EV_WIN] + (size_t)(k0 + row) * EV_IN + 1544 + g * 128 + c4 * 4); }
        for (int i = tid; i < 128 * 32; i += 512) ((f32x4*)Wp)[i] = *(const f32x4*)(a.in[I_EV_POOLW] + (size_t)g * 16384 + i * 4);
        __syncthreads();
        const int e = tid & 127, kq = tid >> 7;
        float acc[4] = {0.f, 0.f, 0.f, 0.f};
        for (int d = 0; d < 128; d += 4) {
            const float w0 = Wp[(d + 0) * 128 + e], w1 = Wp[(d + 1) * 128 + e], w2 = Wp[(d + 2) * 128 + e], w3 = Wp[(d + 3) * 128 + e];
#pragma unroll
            for (int i = 0; i < 4; ++i) { const f32x4 av = *(const f32x4*)(As + (kq * 4 + i) * 128 + d); acc[i] += av[0] * w0 + av[1] * w1 + av[2] * w2 + av[3] * w3; }
        }
        const float sc = a.in[I_EV_POOLS][g * 128 + e];
#pragma unroll
        for (int i = 0; i < 4; ++i) acc[i] *= sc * a.in[I_MIX_PRE][k0 + kq * 4 + i];
        u32x2 w; w.x = pk2(acc[0], acc[1]); w.y = pk2(acc[2], acc[3]);
        *(u32x2*)((bf16_t*)(ws + WS_WIN0) + (size_t)(1536 + g * 128 + e) * 1024 + k0 + kq * 4) = w;
    }
    if (blockIdx.x == gridDim.x - 1) for (int c = tid; c < 1024; c += 512) ((float*)(ws + WS_LU))[c] = -8.f * softplus_f(-a.in[I_OD_LAM][c]);
    __syncthreads();
    float* wf = (float*)lds;
    for (int i = tid; i < 8192; i += 512) { const int hd = i & 7, k = i >> 3; wf[hd * 1024 + k] = a.in[I_EV_WIN][(size_t)k * EV_IN + 1536 + hd]; }
    __syncthreads();
    f32x4 g4[4];
#pragma unroll
    for (int j = 0; j < 4; ++j) g4[j] = *(const f32x4*)(a.in[I_MIX_PRE] + 256 * j + 4 * lane);
    const float bfl = a.in[I_EV_BF][lane & 7];
    bf16_t* XN = (bf16_t*)(ws + WS_XN); float* LOGF = (float*)(ws + WS_LOGF);
    f32x4 vn[4];
    if (gw < T) {
#pragma unroll
        for (int j = 0; j < 4; ++j) vn[j] = __builtin_nontemporal_load((const f32x4*)(a.in[I_X] + (size_t)gw * 1024 + 4 * lane + 256 * j)); }
    for (int row = gw; row < T; row += NGW) {
        f32x4 v[4]; float ss = 0.f;
#pragma unroll
        for (int j = 0; j < 4; ++j) { v[j] = vn[j]; ss += (v[j][0] * v[j][0] + v[j][1] * v[j][1]) + (v[j][2] * v[j][2] + v[j][3] * v[j][3]); }
        if (row + NGW < T) {
#pragma unroll
            for (int j = 0; j < 4; ++j) vn[j] = __builtin_nontemporal_load((const f32x4*)(a.in[I_X] + (size_t)(row + NGW) * 1024 + 4 * lane + 256 * j)); }
        const float rstd = 1.f / sqrtf(wave_sum(ss) * (1.f / 1024.f) + RMS_EPS);
        bf16_t* xo = XN + (size_t)row * 1024 + 4 * lane;
#pragma unroll
        for (int j = 0; j < 4; ++j) { u32x2 w; w.x = pk2(v[j][0], v[j][1]); w.y = pk2(v[j][2], v[j][3]); *(u32x2*)(xo + 256 * j) = w; v[j] = v[j] * rstd * g4[j]; }
        if (lane == 0) ((float*)(ws + WS_RS))[row] = rstd;
        float d[8];
#pragma unroll
        for (int hd = 0; hd < 8; ++hd) { float s = 0.f;
#pragma unroll
            for (int j = 0; j < 4; ++j) { const f32x4 w = *(const f32x4*)(wf + hd * 1024 + 256 * j + 4 * lane); s += (v[j][0] * w[0] + v[j][1] * w[1]) + (v[j][2] * w[2] + v[j][3] * w[3]); }
            d[hd] = s; }
        float e1 = 0.f;
#pragma unroll
        for (int hd = 0; hd < 8; ++hd) { const float tsum = wave_sum(d[hd]); if ((lane & 7) == hd) e1 = tsum; }
        if (lane < 8) { const float z = e1 + bfl; LOGF[(size_t)row * 8 + lane] = fminf(z, 0.f) - log1pf(__expf(-fabsf(z))); }
    }
}
__device__ __forceinline__ void cumsum_phase(const Args& a, unsigned char* lds, int tid, int lane, int wave) {
    float* sm = (float*)lds;
    const float* LOGF = (const float*)(a.ws + WS_LOGF); float* C2 = (float*)(a.ws + WS_C2);
    for (int bh = blockIdx.x; bh < 32; bh += gridDim.x) {
        const int b = bh >> 3, hd = bh & 7;
        float v[16]; float tot = 0.f;
#pragma unroll
        for (int i = 0; i < 16; ++i) { v[i] = LOGF[((size_t)b * SEQ + tid * 16 + i) * 8 + hd]; tot += v[i]; v[i] = tot; }
        float inc = tot;
#pragma unroll
        for (int o = 1; o < 64; o <<= 1) { const float t = __shfl_up(inc, o); if (lane >= o) inc += t; }
        __syncthreads();
        if (lane == 63) sm[wave] = inc;
        __syncthreads();
        float base = 0.f;
        for (int w = 0; w < wave; ++w) base += sm[w];
        const float excl = base + inc - tot;
        float* o = C2 + (size_t)bh * SEQ + tid * 16;
        u32x2* kc = (u32x2*)(a.ws + WS_KC) + (size_t)bh * SEQ + tid * 16;
#pragma unroll
        for (int i = 0; i < 16; ++i) { const float c = (excl + v[i]) * LOG2E; o[i] = c;
            const unsigned hi = pk2(c, 0.f) & 0xffffu; const float r1 = c - bf_lo(hi); const unsigned mid = pk2(r1, 0.f) & 0xffffu; const float r2 = r1 - bf_lo(mid); const unsigned lo = pk2(r2, 0.f) & 0xffffu;
            u32x2 w; w.x = hi | (mid << 16); w.y = lo; kc[i] = w; }
    }
    __syncthreads();
}
__device__ __forceinline__ void pool_phase(const Args& a, int tid) {
    const bf16_t* __restrict__ U = (const bf16_t*)(a.ws + WS_QKVU) + (size_t)3 * T * 512; bf16_t* __restrict__ CAT = (bf16_t*)(a.ws + WS_CAT);
    const int ch = tid & 63, ts = tid >> 6, g = ch >> 4, w = 2 << g;
    for (int u = blockIdx.x; u < T / 128; u += gridDim.x) {
        const int t0 = u * 128 + ts * 16, pos0 = t0 & (SEQ - 1);
        const bf16_t* up = U + (size_t)t0 * 512 + ch * 8;
        float s[8];
#pragma unroll
        for (int i = 0; i < 8; ++i) s[i] = 0.f;
        for (int j = 1; j <= w; ++j) if (pos0 - j >= 0) { const u32x4 x = *(const u32x4*)(up - (long)j * 512);
            s[0] += bf_lo(x.x); s[1] += bf_hi(x.x); s[2] += bf_lo(x.y); s[3] += bf_hi(x.y); s[4] += bf_lo(x.z); s[5] += bf_hi(x.z); s[6] += bf_lo(x.w); s[7] += bf_hi(x.w); }
        for (int i = 0; i < 16; ++i) {
            const int pos = pos0 + i;
            const u32x4 x = *(const u32x4*)(up + (size_t)i * 512);
            const float c[8] = {bf_lo(x.x), bf_hi(x.x), bf_lo(x.y), bf_hi(x.y), bf_lo(x.z), bf_hi(x.z), bf_lo(x.w), bf_hi(x.w)};
#pragma unroll
            for (int k = 0; k < 8; ++k) s[k] += c[k];
            if (pos >= w) { const u32x4 y = *(const u32x4*)(up + (long)(i - w) * 512);
                s[0] -= bf_lo(y.x); s[1] -= bf_hi(y.x); s[2] -= bf_lo(y.y); s[3] -= bf_hi(y.y); s[4] -= bf_lo(y.z); s[5] -= bf_hi(y.z); s[6] -= bf_lo(y.w); s[7] -= bf_hi(y.w); }
            const float inv = 1.f / (float)(pos + 1 < w ? pos + 1 : w);
            u32x4 o; o.x = pk2(s[0] * inv - c[0], s[1] * inv - c[1]); o.y = pk2(s[2] * inv - c[2], s[3] * inv - c[3]); o.z = pk2(s[4] * inv - c[4], s[5] * inv - c[5]); o.w = pk2(s[6] * inv - c[6], s[7] * inv - c[7]);
            *(u32x4*)(CAT + (size_t)(t0 + i) * 1024 + 512 + ch * 8) = o;
        }
    }
}
__device__ __forceinline__ bf16x8 pack8(const f32x16& S, int o) {
    u32x4 w; w.x = pk2(S[o], S[o + 1]); w.y = pk2(S[o + 2], S[o + 3]); w.z = pk2(S[o + 4], S[o + 5]); w.w = pk2(S[o + 6], S[o + 7]);
    return __builtin_bit_cast(bf16x8, w);
}
typedef short s16x4 __attribute__((ext_vector_type(4)));
__device__ __forceinline__ s16x4 vtr(const unsigned char* p) { return __builtin_bit_cast(s16x4, __builtin_amdgcn_ds_read_tr16_b64_v4i16((LAS s16x4*)p)); }
__device__ __forceinline__ void attn_unit(unsigned char* lds, const bf16_t* __restrict__ Qg, const bf16_t* __restrict__ Kg, const bf16_t* __restrict__ Vg, const float* __restrict__ Cg,
                                          const u32x2* __restrict__ KCg, const unsigned* kmaxp, bf16_t* __restrict__ CAT, int b, int h, int qb, int tid, int lane, int wave) {
    constexpr int KS = 144, TB = 64 * KS, VS = 192, VTB = 64 * VS; constexpr float ATT_THR = 12.f;
    unsigned char* Kb = lds; unsigned char* Vb = lds + 2 * TB; u32x2* KCb = (u32x2*)(lds + 2 * TB + 2 * VTB);
    const int r32 = lane & 31, hh = lane >> 5;
    const size_t rowbase = (size_t)b * SEQ;
    const int q0 = qb * 256 + wave * 32, NT = 4 * (qb + 1);
    bf16x8 qf[4];
    { const bf16_t* qp = Qg + (rowbase + q0 + r32) * 512 + h * 64 + hh * 8;
#pragma unroll
      for (int ks = 0; ks < 4; ++ks) qf[ks] = *(const bf16x8*)(qp + ks * 16); }
    const float cq = Cg[(size_t)(b * 8 + h) * SEQ + q0 + r32];
    const unsigned qa_w = hh ? 0u : 0xBF80BF80u, qa_w2 = hh ? 0u : 0x0000BF80u, kmask = hh ? 0u : 0xffffffffu;
    const bf16x8 qaug = __builtin_bit_cast(bf16x8, (u32x4){qa_w, qa_w2, 0u, 0u});
    float ql1 = 0.f;
#pragma unroll
    for (int ks = 0; ks < 4; ++ks) { const u32x4 w = __builtin_bit_cast(u32x4, qf[ks]);
#pragma unroll
        for (int i = 0; i < 4; ++i) { const float lo = bf_lo(w[i]), hi = bf_hi(w[i]); ql1 += lo * lo + hi * hi; } }
    ql1 += __shfl_xor(ql1, 32);
#pragma unroll
    for (int o = 1; o < 32; o <<= 1) ql1 = fmaxf(ql1, __shfl_xor(ql1, o));
    float* red = (float*)(lds + 2 * TB + 2 * VTB + 1024);
    if (lane == 0) red[wave] = ql1;
    __syncthreads();
    float qmx = red[0];
#pragma unroll
    for (int w = 1; w < 8; ++w) qmx = fmaxf(qmx, red[w]);
    const float qkb = sqrtf(qmx * 2.f * __uint_as_float(__hip_atomic_load(kmaxp, __ATOMIC_RELAXED, __HIP_MEMORY_SCOPE_AGENT))) * 1.03f;
    int t_begin;
    { const float* cseq = Cg + (size_t)(b * 8 + h) * SEQ; const float cfirst = cseq[256 * qb];
      const unsigned long long b0 = __ballot((lane < NT) && ((64 * lane + 63 >= 256 * qb) || (cfirst - cseq[64 * lane + 63] + 2.f * qkb >= -40.f)));
      if (b0 != 0ull) t_begin = __builtin_ctzll(b0);
      else { const int tt = lane + 64; const unsigned long long b1 = __ballot((tt < NT) && ((64 * tt + 63 >= 256 * qb) || (cfirst - cseq[64 * tt + 63] + 2.f * qkb >= -40.f))); t_begin = 64 + __builtin_ctzll(b1); }
      t_begin = __builtin_amdgcn_readfirstlane(t_begin); }
    const bf16_t* ksrc = Kg + (rowbase + (tid >> 3)) * 512 + h * 64 + (tid & 7) * 8;
    const bf16_t* vsrc = Vg + (rowbase + (tid >> 3)) * 512 + h * 64 + (tid & 7) * 8;
    const u32x2* csrc = KCg + (size_t)(b * 8 + h) * SEQ;
    const int kdst = (tid >> 3) * KS + (tid & 7) * 16;
    const int vdst = (tid >> 3) * VS + (tid & 7) * 16;
    const int vtr_off = (4 * hh + ((lane & 15) >> 2)) * VS + (16 * ((lane >> 4) & 1) + 4 * (lane & 3)) * 2;
    u32x4 kreg, vreg; u32x2 creg = (u32x2){0u, 0u};
    kreg = *(const u32x4*)(ksrc + (size_t)t_begin * 64 * 512); vreg = *(const u32x4*)(vsrc + (size_t)t_begin * 64 * 512); if (tid < 64) creg = csrc[t_begin * 64 + tid];
#define ATT_STAGE(buf) do { *(u32x4*)(Kb + (buf) * TB + kdst) = kreg; *(u32x4*)(Vb + (buf) * VTB + vdst) = vreg; \
        if (tid < 64) KCb[(buf) * 64 + tid] = creg; } while (0)
    ATT_STAGE(t_begin & 1);
    __syncthreads();
    f32x16 O0, O1, cinit;
#pragma unroll
    for (int r = 0; r < 16; ++r) { O0[r] = 0.f; O1[r] = 0.f; cinit[r] = cq; }
    float mref = 0.f, l = 0.f;
    for (int t = t_begin; t < NT; ++t) {
        const int cur = t & 1;
        if (t + 1 < NT) { kreg = *(const u32x4*)(ksrc + (size_t)(t + 1) * 64 * 512); vreg = *(const u32x4*)(vsrc + (size_t)(t + 1) * 64 * 512); if (tid < 64) creg = csrc[(t + 1) * 64 + tid]; }
        if (64 * t <= q0 + 31) {
            const unsigned char* kb = Kb + cur * TB + r32 * KS + hh * 16;
            const u32x2 c0w = KCb[cur * 64 + r32], c1w = KCb[cur * 64 + 32 + r32];
            const bf16x8 ka0 = __builtin_bit_cast(bf16x8, (u32x4){c0w.x & kmask, c0w.y & kmask, 0u, 0u}), ka1 = __builtin_bit_cast(bf16x8, (u32x4){c1w.x & kmask, c1w.y & kmask, 0u, 0u});
            __builtin_amdgcn_s_setprio(1);
            f32x16 S0 = __builtin_amdgcn_mfma_f32_32x32x16_bf16(ka0, qaug, cinit, 0, 0, 0), S1 = __builtin_amdgcn_mfma_f32_32x32x16_bf16(ka1, qaug, cinit, 0, 0, 0);
#pragma unroll
            for (int ks = 0; ks < 4; ++ks) { const bf16x8 k0 = *(const bf16x8*)(kb + ks * 32), k1 = *(const bf16x8*)(kb + 32 * KS + ks * 32);
                S0 = __builtin_amdgcn_mfma_f32_32x32x16_bf16(k0, qf[ks], S0, 0, 0, 0); S1 = __builtin_amdgcn_mfma_f32_32x32x16_bf16(k1, qf[ks], S1, 0, 0, 0); }
            __builtin_amdgcn_s_setprio(0);
            if (64 * t + 63 > q0) { const int qg = q0 + r32;
#pragma unroll
                for (int r = 0; r < 16; ++r) { const int kv = 64 * t + (r & 3) + 8 * (r >> 2) + 4 * hh; if (kv > qg) S0[r] = -INFINITY; if (kv + 32 > qg) S1[r] = -INFINITY; } }
            float mx = fmaxf(fmaxf(S0[0], S1[0]), S0[1]);
#pragma unroll
            for (int r = 1; r < 16; ++r) mx = fmaxf(fmaxf(mx, S1[r]), r + 1 < 16 ? S0[r + 1] : S1[r]);
            mx = fmaxf(mx, __shfl_xor(mx, 32));
            if (__builtin_expect(__any(mx > ATT_THR), 0)) {
                const float dl = fmaxf(mx, 0.f), f = __builtin_amdgcn_exp2f(-dl); mref += dl; l *= f;
#pragma unroll
                for (int r = 0; r < 16; ++r) { S0[r] -= dl; S1[r] -= dl; O0[r] *= f; O1[r] *= f; cinit[r] = cq - mref; }
            }
            float ps = 0.f;
#pragma unroll
            for (int r = 0; r < 16; ++r) { S0[r] = __builtin_amdgcn_exp2f(S0[r]); S1[r] = __builtin_amdgcn_exp2f(S1[r]); ps += S0[r] + S1[r]; }
            l += ps;
            bf16x8 pf[4]; pf[0] = pack8(S0, 0); pf[1] = pack8(S0, 8); pf[2] = pack8(S1, 0); pf[3] = pack8(S1, 8);
            const unsigned char* vb = Vb + cur * VTB + vtr_off;
            __builtin_amdgcn_s_setprio(1);
#pragma unroll
            for (int kk = 0; kk < 4; ++kk) {
                const s16x4 l0 = vtr(vb + (16 * kk) * VS), h0 = vtr(vb + (16 * kk + 8) * VS), l1 = vtr(vb + (16 * kk) * VS + 64), h1 = vtr(vb + (16 * kk + 8) * VS + 64);
                const bf16x8 v0 = (bf16x8){l0[0], l0[1], l0[2], l0[3], h0[0], h0[1], h0[2], h0[3]}, v1 = (bf16x8){l1[0], l1[1], l1[2], l1[3], h1[0], h1[1], h1[2], h1[3]};
                O0 = __builtin_amdgcn_mfma_f32_32x32x16_bf16(v0, pf[kk], O0, 0, 0, 0); O1 = __builtin_amdgcn_mfma_f32_32x32x16_bf16(v1, pf[kk], O1, 0, 0, 0); }
            __builtin_amdgcn_s_setprio(0);
        }
        if (t + 1 < NT) ATT_STAGE(cur ^ 1);
        __syncthreads();
    }
#undef ATT_STAGE
    const float inv = 1.f / (l + __shfl_xor(l, 32));
    bf16_t* op = CAT + (rowbase + q0 + r32) * 1024 + h * 64 + 4 * hh;
#pragma unroll
    for (int g = 0; g < 4; ++g) {
        u32x2 w0, w1; w0.x = pk2(O0[4 * g] * inv, O0[4 * g + 1] * inv); w0.y = pk2(O0[4 * g + 2] * inv, O0[4 * g + 3] * inv);
        w1.x = pk2(O1[4 * g] * inv, O1[4 * g + 1] * inv); w1.y = pk2(O1[4 * g + 2] * inv, O1[4 * g + 3] * inv);
        *(u32x2*)(op + 8 * g) = w0; *(u32x2*)(op + 32 + 8 * g) = w1; }
}
__device__ __forceinline__ void attn_phase(const Args& a, unsigned char* lds, int tid, int lane, int wave) {
    const bf16_t* Q = (const bf16_t*)(a.ws + WS_QKVU); const bf16_t* K = Q + (size_t)T * 512; const bf16_t* V = K + (size_t)T * 512;
    const float* C2 = (const float*)(a.ws + WS_C2); bf16_t* CAT = (bf16_t*)(a.ws + WS_CAT);
    unsigned* ctl = (unsigned*)(a.ws + WS_CTL2);
    volatile int* tk = (volatile int*)(lds + 131072 + 1024);
    const int own = (int)(__builtin_amdgcn_s_getreg((3 << 11) | 20) & 7u);
    for (int qi = 0; qi < 8; ++qi) {
        const int q = (own + qi) & 7;
        for (;;) {
            __syncthreads();
            if (wave == 0 && lane == 0) *tk = (int)__hip_atomic_fetch_add(ctl + 64 * (1 + q), 1u, __ATOMIC_RELAXED, __HIP_MEMORY_SCOPE_AGENT);
            __syncthreads();
            const int ticket = *tk;
            if (ticket >= 128) break;
            const int qb = 31 - (ticket >> 2), bh = 4 * q + (ticket & 3);
            attn_unit(lds, Q, K, V, C2, (const u32x2*)(a.ws + WS_KC), ctl + bh, CAT, bh >> 3, bh & 7, qb, tid, lane, wave);
        }
    }
}
template <bool XIN_F32, bool LAST>
__device__ __forceinline__ void ew_phase(const bf16_t* __restrict__ Mb, const float* __restrict__ xin32, const bf16_t* __restrict__ XBin, bf16_t* __restrict__ XBout, float* __restrict__ xout32,
                                         const float* __restrict__ gpost, float* __restrict__ RS, int lane, int wave) {
    const int gw = blockIdx.x * 8 + wave, NGW = gridDim.x * 8;
    f32x4 gp[4];
#pragma unroll
    for (int j = 0; j < 4; ++j) gp[j] = *(const f32x4*)(gpost + 256 * j + 4 * lane);
    for (int row0 = gw; row0 < T; row0 += 4 * NGW) {
        u32x2 mw[4][4]; u32x2 xw[4][4]; f32x4 xf[XIN_F32 ? 4 : 1][4];
#pragma unroll
        for (int k = 0; k < 4; ++k) { const int row = row0 + k * NGW; if (row < T) { const size_t off = (size_t)row * 1024 + 4 * lane;
#pragma unroll
            for (int j = 0; j < 4; ++j) { mw[k][j] = __builtin_nontemporal_load((const u32x2*)(Mb + off + 256 * j));
                if (XIN_F32) xf[XIN_F32 ? k : 0][j] = *(const f32x4*)(xin32 + off + 256 * j); else xw[k][j] = *(const u32x2*)(XBin + off + 256 * j); } } }
#pragma unroll
        for (int k = 0; k < 4; ++k) { const int row = row0 + k * NGW; if (row < T) { const size_t off = (size_t)row * 1024 + 4 * lane;
            f32x4 mv[4], xv[4]; float ss = 0.f;
#pragma unroll
            for (int j = 0; j < 4; ++j) { mv[j] = (f32x4){bf_lo(mw[k][j].x), bf_hi(mw[k][j].x), bf_lo(mw[k][j].y), bf_hi(mw[k][j].y)};
                if (XIN_F32) xv[j] = xf[XIN_F32 ? k : 0][j]; else xv[j] = (f32x4){bf_lo(xw[k][j].x), bf_hi(xw[k][j].x), bf_lo(xw[k][j].y), bf_hi(xw[k][j].y)};
                ss += (mv[j][0] * mv[j][0] + mv[j][1] * mv[j][1]) + (mv[j][2] * mv[j][2] + mv[j][3] * mv[j][3]); }
            const float rstd = 1.f / sqrtf(wave_sum(ss) * (1.f / 1024.f) + RMS_EPS);
            float s2 = 0.f;
#pragma unroll
            for (int j = 0; j < 4; ++j) { xv[j] = xv[j] + mv[j] * rstd * gp[j];
                if (LAST) __builtin_nontemporal_store(xv[j], (f32x4*)(xout32 + off + 256 * j));
                else { u32x2 w; w.x = pk2(xv[j][0], xv[j][1]); w.y = pk2(xv[j][2], xv[j][3]); *(u32x2*)(XBout + off + 256 * j) = w;
                    const f32x4 q = (f32x4){bf_lo(w.x), bf_hi(w.x), bf_lo(w.y), bf_hi(w.y)};
                    s2 += (q[0] * q[0] + q[1] * q[1]) + (q[2] * q[2] + q[3] * q[3]); } }
            if (!LAST) { const float r2 = 1.f / sqrtf(wave_sum(s2) * (1.f / 1024.f) + RMS_EPS); if (lane == 0) RS[row] = r2; } } }
    }
}
__device__ __forceinline__ void conv_phase(const Args& a, int tid) {
    const bf16_t* __restrict__ XR = (const bf16_t*)(a.ws + WS_XR); bf16_t* __restrict__ XC = (bf16_t*)(a.ws + WS_XC);
    const int ch = tid & 127, tq = tid >> 7, c = ch * 8;
    float w[4][8], bb[8];
#pragma unroll
    for (int i = 0; i < 8; ++i) { bb[i] = a.in[I_OD_CONVB][c + i];
#pragma unroll
        for (int j = 0; j < 4; ++j) w[j][i] = a.in[I_OD_CONVW][j * 1024 + c + i]; }
    for (int u = blockIdx.x; u < T / 128; u += gridDim.x) {
        const int t0 = u * 128 + tq * 32, pos0 = t0 & (SEQ - 1);
        float x3[8], x2[8], x1[8];
#define LDROW(dst, tt, ok) do { u32x4 x_ = (u32x4){0u, 0u, 0u, 0u}; if (ok) x_ = __builtin_nontemporal_load((const u32x4*)(XR + (size_t)(tt) * 1024 + c)); \
            dst[0] = bf_lo(x_.x); dst[1] = bf_hi(x_.x); dst[2] = bf_lo(x_.y); dst[3] = bf_hi(x_.y); dst[4] = bf_lo(x_.z); dst[5] = bf_hi(x_.z); dst[6] = bf_lo(x_.w); dst[7] = bf_hi(x_.w); } while (0)
        LDROW(x3, t0 - 3, pos0 >= 3); LDROW(x2, t0 - 2, pos0 >= 2); LDROW(x1, t0 - 1, pos0 >= 1);
        for (int i = 0; i < 32; ++i) {
            const int t = t0 + i; float x0[8]; LDROW(x0, t, true);
            float o[8];
#pragma unroll
            for (int k = 0; k < 8; ++k) { o[k] = bb[k] + w[0][k] * x3[k] + w[1][k] * x2[k] + w[2][k] * x1[k] + w[3][k] * x0[k]; x3[k] = x2[k]; x2[k] = x1[k]; x1[k] = x0[k]; }
            u32x4 ow; ow.x = pk2(o[0], o[1]); ow.y = pk2(o[2], o[3]); ow.z = pk2(o[4], o[5]); ow.w = pk2(o[6], o[7]);
            *(u32x4*)(XC + ((size_t)(c >> 8) * T + t) * 256 + (c & 255)) = ow;
        }
#undef LDROW
    }
}
#define SCAN_LD2(A, B, i0) do { _Pragma("unroll") for (int i_ = 0; i_ < 16; ++i_) { A[i_] = *(const unsigned*)(ap + (size_t)((i0) + i_) * 1024); B[i_] = *(const unsigned*)(bp + (size_t)((i0) + i_) * 1024); } } while (0)
#define SCAN_LD3(A, B, Gv, i0) do { _Pragma("unroll") for (int i_ = 0; i_ < 16; ++i_) { A[i_] = *(const unsigned*)(ap + (size_t)((i0) + i_) * 1024); B[i_] = *(const unsigned*)(bp + (size_t)((i0) + i_) * 1024); \
        Gv[i_] = __builtin_nontemporal_load((const unsigned*)(gp + (size_t)((i0) + i_) * 1024)); } } while (0)
__device__ __forceinline__ void scan1_phase(const Args& a, int tid) {
    const bf16_t* __restrict__ LA = (const bf16_t*)(a.ws + WS_A32); const bf16_t* __restrict__ BV = (const bf16_t*)(a.ws + WS_BV);
    float* __restrict__ SP = (float*)(a.ws + WS_SP); float* __restrict__ SH = (float*)(a.ws + WS_SH);
    for (int u = blockIdx.x; u < 256; u += gridDim.x) {
        const size_t t0 = (size_t)(u >> 6) * SEQ + (u & 63) * 128;
        float h0 = 0.f, h1 = 0.f, l0 = 0.f, l1 = 0.f;
        const bf16_t* ap = LA + t0 * 1024 + 2 * tid; const bf16_t* bp = BV + t0 * 1024 + 2 * tid;
        unsigned A0[16], B0[16], A1[16], B1[16];
#define SCAN1_COMP(A, B) do { _Pragma("unroll") for (int i_ = 0; i_ < 16; ++i_) { const unsigned aw = A[i_], bw = B[i_]; \
            h0 = __builtin_amdgcn_exp2f(bf_lo(aw)) * h0 + bf_lo(bw); h1 = __builtin_amdgcn_exp2f(bf_hi(aw)) * h1 + bf_hi(bw); l0 += bf_lo(aw); l1 += bf_hi(aw); } } while (0)
        SCAN_LD2(A0, B0, 0);
#pragma unroll
        for (int g = 0; g < 8; g += 2) {
            SCAN_LD2(A1, B1, (g + 1) * 16);
            SCAN1_COMP(A0, B0);
            if (g + 2 < 8) SCAN_LD2(A0, B0, (g + 2) * 16);
            SCAN1_COMP(A1, B1);
        }
#undef SCAN1_COMP
        *(f32x2*)(SP + (size_t)u * 1024 + 2 * tid) = (f32x2){__builtin_amdgcn_exp2f(l0), __builtin_amdgcn_exp2f(l1)}; *(f32x2*)(SH + (size_t)u * 1024 + 2 * tid) = (f32x2){h0, h1};
    }
}
__device__ __forceinline__ void scan2_phase(const Args& a, int tid) {
    const bf16_t* __restrict__ LA = (const bf16_t*)(a.ws + WS_A32); const bf16_t* __restrict__ BV = (const bf16_t*)(a.ws + WS_BV); const bf16_t* __restrict__ Gb = (const bf16_t*)(a.ws + WS_G);
    const float* __restrict__ SP = (const float*)(a.ws + WS_SP); const float* __restrict__ SH = (const float*)(a.ws + WS_SH); bf16_t* __restrict__ YG = (bf16_t*)(a.ws + WS_YG);
    for (int u = blockIdx.x; u < 256; u += gridDim.x) {
        const int b = u >> 6, ck = u & 63; const size_t t0 = (size_t)b * SEQ + ck * 128;
        const bf16_t* ap = LA + t0 * 1024 + 2 * tid; const bf16_t* bp = BV + t0 * 1024 + 2 * tid; const bf16_t* gp = Gb + t0 * 1024 + 2 * tid; bf16_t* yp = YG + t0 * 1024 + 2 * tid;
        unsigned A0[16], B0[16], G0[16], A1[16], B1[16], G1[16];
        SCAN_LD3(A0, B0, G0, 0);
        float h0 = 0.f, h1 = 0.f;
#pragma unroll 8
        for (int c = 0; c < ck; ++c) { const f32x2 p = *(const f32x2*)(SP + (size_t)(b * 64 + c) * 1024 + 2 * tid), s = *(const f32x2*)(SH + (size_t)(b * 64 + c) * 1024 + 2 * tid);
            h0 = p[0] * h0 + s[0]; h1 = p[1] * h1 + s[1]; }
#define SCAN2_COMP(A, B, Gv, i0) do { _Pragma("unroll") for (int i_ = 0; i_ < 16; ++i_) { const unsigned aw = A[i_], bw = B[i_], gwd = Gv[i_]; \
            h0 = __builtin_amdgcn_exp2f(bf_lo(aw)) * h0 + bf_lo(bw); h1 = __builtin_amdgcn_exp2f(bf_hi(aw)) * h1 + bf_hi(bw); \
            *(unsigned*)(yp + (size_t)((i0) + i_) * 1024) = pk2(h0 * bf_lo(gwd), h1 * bf_hi(gwd)); } } while (0)
#pragma unroll
        for (int g = 0; g < 8; g += 2) {
            SCAN_LD3(A1, B1, G1, (g + 1) * 16);
            SCAN2_COMP(A0, B0, G0, g * 16);
            if (g + 2 < 8) SCAN_LD3(A0, B0, G0, (g + 2) * 16);
            SCAN2_COMP(A1, B1, G1, (g + 1) * 16);
        }
#undef SCAN2_COMP
    }
}
#undef SCAN_LD2
#undef SCAN_LD3
__device__ __forceinline__ void grid_bar(unsigned* cnt, unsigned target, int wave_s) {
    asm volatile("s_waitcnt vmcnt(0) lgkmcnt(0)" ::: "memory");
    __syncthreads();
    if (wave_s == 0) {
        if (__builtin_amdgcn_mbcnt_hi(~0u, __builtin_amdgcn_mbcnt_lo(~0u, 0u)) == 0u) {
            __builtin_amdgcn_fence(__ATOMIC_RELEASE, "agent");
            asm volatile("s_waitcnt vmcnt(0)" ::: "memory");
            __hip_atomic_fetch_add(cnt, 1u, __ATOMIC_RELAXED, __HIP_MEMORY_SCOPE_AGENT);
            while (__hip_atomic_load(cnt, __ATOMIC_RELAXED, __HIP_MEMORY_SCOPE_AGENT) < target) __builtin_amdgcn_s_sleep(2);
        }
        __builtin_amdgcn_fence(__ATOMIC_ACQUIRE, "agent");
        asm volatile("s_waitcnt vmcnt(0)" ::: "memory");
    }
    __syncthreads();
}
#define RLX_AGENT __ATOMIC_RELAXED, __HIP_MEMORY_SCOPE_AGENT
#define XB_TMO      128
#define XB_XCNT(j)  (256  + 64 * (j))
#define XB_XSUB(j)  (1280 + 64 * (j))
#define XB_XGEN(j)  (2304 + 64 * (j))
#define XB_TOP      3328
#define XB_TOPGEN   3392
#define XCD_BAR_WORDS 3456
#define XB_SPIN_CAP (1u << 18)

__device__ __forceinline__ unsigned xb_ld(unsigned* p)              { return __hip_atomic_load(p, __ATOMIC_RELAXED, __HIP_MEMORY_SCOPE_AGENT); }
__device__ __forceinline__ unsigned xb_add(unsigned* p, unsigned v) { return __hip_atomic_fetch_add(p, v, __ATOMIC_RELAXED, __HIP_MEMORY_SCOPE_AGENT); }
__device__ __forceinline__ unsigned xb_xcc_id() { return (unsigned)__builtin_amdgcn_s_getreg((3 << 11) | 20) & 0xFu; }
#define XB_SPIN(cond, bar) do { unsigned _sp = 0; while (cond) { __builtin_amdgcn_s_sleep(1); \
    if ((++_sp & 255u) == 0u) { if (xb_ld(&(bar)[XB_TMO])) break; if (_sp > XB_SPIN_CAP) { atomicAdd(&(bar)[XB_TMO], 1u); break; } } } } while (0)

struct XcdBarrier {
    unsigned* bar; unsigned x;
    volatile LAS unsigned* st;
};

__device__ __forceinline__ XcdBarrier xcd_barrier_post(unsigned* bar, volatile LAS unsigned* st, bool is_t0) {
    XcdBarrier b; b.bar = bar; b.x = xb_xcc_id(); b.st = st;
    if (is_t0) (void)xb_add(&bar[XB_XCNT(b.x)], 1u);
    return b;
}
__device__ __forceinline__ void xcd_barrier_complete(unsigned* bar, unsigned x, unsigned& nloc, unsigned& nx) {
    const unsigned G = gridDim.x * gridDim.y * gridDim.z;
    unsigned sum, cnt, mine, sp = 0u;
    for (;;) {
        sum = 0u; cnt = 0u; mine = 0u;
#pragma unroll
        for (unsigned j = 0; j < 16; ++j) { const unsigned c = xb_ld(&bar[XB_XCNT(j)]); sum += c; cnt += (c > 0u) ? 1u : 0u; mine = (j == x) ? c : mine; }
        if (sum == G) break;
        __builtin_amdgcn_s_sleep(1);
        if ((++sp & 255u) == 0u) { if (xb_ld(&bar[XB_TMO])) break; if (sp > XB_SPIN_CAP) { atomicAdd(&bar[XB_TMO], 1u); break; } }
    }
    nloc = mine > 0u ? mine : 1u; nx = cnt > 0u ? cnt : 1u;
}

__device__ __forceinline__ void xcd_barrier(const XcdBarrier& b, bool is_t0) {
    asm volatile("s_waitcnt vmcnt(0)" ::: "memory");
    __syncthreads();
    if (is_t0) {
        unsigned* bar = b.bar;
        __builtin_amdgcn_s_waitcnt(0);
        unsigned nloc = b.st[0], nx = b.st[1];
        if (nloc == 0u) { xcd_barrier_complete(bar, b.x, nloc, nx); b.st[0] = nloc; b.st[1] = nx; }
        const unsigned old = xb_add(&bar[XB_XSUB(b.x)], 1u);
        const unsigned gen = old / nloc;
        if (old + 1u == (gen + 1u) * nloc) {
            __builtin_amdgcn_fence(__ATOMIC_RELEASE, "agent");
            asm volatile("s_waitcnt vmcnt(0)" ::: "memory");
            const unsigned og = xb_add(&bar[XB_TOP], 1u);
            const unsigned tg = og / nx;
            if (og + 1u == (tg + 1u) * nx) xb_add(&bar[XB_TOPGEN], 1u);
            else XB_SPIN(xb_ld(&bar[XB_TOPGEN]) == tg, bar);
            __builtin_amdgcn_fence(__ATOMIC_ACQUIRE, "agent");
            asm volatile("s_waitcnt vmcnt(0)" ::: "memory");
        } else {
            XB_SPIN(xb_ld(&bar[XB_TOPGEN]) == gen, bar);
            __builtin_amdgcn_fence(__ATOMIC_ACQUIRE, "agent");
            asm volatile("s_waitcnt vmcnt(0)" ::: "memory");
        }
    }
    __syncthreads();
}

__global__ void __launch_bounds__(512, 2) fwd_mega(Args a) {
    extern __shared__ __attribute__((aligned(16))) unsigned char lds[];
    cg::grid_group grid = cg::this_grid();
    const int wave_s = __builtin_amdgcn_readfirstlane((int)threadIdx.x >> 6);
    int tid, lane, wave;
    const int lo = a.ph_lo, hi = a.ph_hi, G = gridDim.x, bx = blockIdx.x;
    const bool is_t0 = (wave_s == 0) && (__builtin_amdgcn_mbcnt_hi(~0u, __builtin_amdgcn_mbcnt_lo(~0u, 0u)) == 0u);
    volatile LAS unsigned* bst = (volatile LAS unsigned*)((LAS unsigned char*)lds + 131072 + 512);
    if (is_t0) { bst[0] = 0u; bst[1] = 0u; }
    __syncthreads();
    XcdBarrier xbar; xbar.bar = (unsigned*)(a.ws + WS_BAR); xbar.x = 0; xbar.st = bst;
    unsigned char* ws = a.ws;
    PG8_LAS unsigned char* lds3 = (PG8_LAS unsigned char*)lds;
    bf16_t* XN = (bf16_t*)(ws + WS_XN); bf16_t* Mb = (bf16_t*)(ws + WS_M);
    const bool rs_in_lds = (G == 256);
    const float* RSg = (const float*)(ws + WS_RS); const LAS float* rsl = (const LAS float*)((LAS unsigned char*)lds + LDS_RS_OFF); const int rbase = 4096 * (bx & 7);
#define RS_TO_LDS() do { for (int i_ = tid; i_ < 1024; i_ += 512) ((LAS f32x4*)((LAS unsigned char*)lds + LDS_RS_OFF))[i_] = *(const f32x4*)(RSg + rbase + 4 * i_); __syncthreads(); } while (0)
#define IN(k) (lo <= (k) && (k) < hi)
#define FRESH() do { lane = (int)__builtin_amdgcn_mbcnt_hi(~0u, __builtin_amdgcn_mbcnt_lo(~0u, 0u)); asm volatile("" : "+v"(lane)); tid = wave_s * 64 + lane; wave = wave_s; } while (0)
#define SEAM(k) do { if (IN(k) && IN((k) + 1)) { if ((k) == 0) { grid.sync(); xbar = xcd_barrier_post((unsigned*)(ws + WS_BAR), bst, is_t0); } else { xcd_barrier(xbar, is_t0); if (PROBE_DUP_BAR) xcd_barrier(xbar, is_t0); } } } while (0)
    if (IN(0)) for (int rep_ = 0; rep_ <= ((PROBE_DUP_MASK >> 0) & 1); ++rep_) { if (rep_) __syncthreads(); FRESH(); if (bx == 0) for (int i_ = tid; i_ < XCD_BAR_WORDS; i_ += 512) __hip_atomic_store((unsigned*)(ws + WS_BAR) + i_, 0u, __ATOMIC_RELAXED, __HIP_MEMORY_SCOPE_AGENT); if (bx == 0) for (int i_ = tid; i_ < 64 * 9; i_ += 512) __hip_atomic_store((unsigned*)(ws + WS_CTL2) + i_, 0u, __ATOMIC_RELAXED, __HIP_MEMORY_SCOPE_AGENT); phase0(a, lds, tid, lane, wave); } SEAM(0);
    if (IN(1)) for (int rep_ = 0; rep_ <= ((PROBE_DUP_MASK >> 1) & 1); ++rep_) { if (rep_) __syncthreads(); FRESH(); cumsum_phase(a, lds, tid, lane, wave);
        pg8::Gemm g{XN, (const bf16_t*)(ws + WS_WIN0), T, 2048, 1024}; pg8::StaticOrder S; S.init(T, 2048, G, bx); if (rs_in_lds) { RS_TO_LDS(); EpiQKVU<true> E{(bf16_t*)(ws + WS_QKVU), (unsigned*)(ws + WS_CTL2), RowScale<true>{RSg, rsl, rbase}}; pg8::gemm_phase<EpiQKVU<true>, pg8::StaticOrder, true, true>(lds3, g, S, E, tid); }
        else { EpiQKVU<false> E{(bf16_t*)(ws + WS_QKVU), (unsigned*)(ws + WS_CTL2), RowScale<false>{RSg, rsl, rbase}}; pg8::gemm_phase<EpiQKVU<false>, pg8::StaticOrder, true, true>(lds3, g, S, E, tid); } } SEAM(1);
    if (IN(2)) for (int rep_ = 0; rep_ <= ((PROBE_DUP_MASK >> 2) & 1); ++rep_) { if (rep_) __syncthreads(); FRESH(); pool_phase(a, tid); attn_phase(a, lds, tid, lane, wave); } SEAM(2);
    if (IN(3)) for (int rep_ = 0; rep_ <= ((PROBE_DUP_MASK >> 3) & 1); ++rep_) { if (rep_) __syncthreads(); FRESH(); pg8::Gemm g{(const bf16_t*)(ws + WS_CAT), (const bf16_t*)(ws + WS_WOUT0), T, 1024, 1024}; pg8::StaticOrder S; S.init(T, 1024, G, bx); EpiPlain E{Mb, 1024};
        pg8::gemm_phase<EpiPlain, pg8::StaticOrder, true, true>(lds3, g, S, E, tid); } SEAM(3);
    if (IN(4)) for (int rep_ = 0; rep_ <= ((PROBE_DUP_MASK >> 4) & 1); ++rep_) { if (rep_) __syncthreads(); FRESH(); ew_phase<false, false>(Mb, nullptr, XN, XN, nullptr, a.in[I_MIX_POST], (float*)(ws + WS_RS), lane, wave); } SEAM(4);
    if (IN(5)) for (int rep_ = 0; rep_ <= ((PROBE_DUP_MASK >> 5) & 1); ++rep_) { if (rep_) __syncthreads(); FRESH(); pg8::Gemm g{XN, (const bf16_t*)(ws + WS_WGU0), T, 2 * DFF, 1024}; pg8::StaticOrder S; S.init(T, 2 * DFF, G, bx); if (rs_in_lds) { RS_TO_LDS(); EpiSwiglu<true> E{(bf16_t*)(ws + WS_H), RowScale<true>{RSg, rsl, rbase}}; pg8::gemm_phase<EpiSwiglu<true>, pg8::StaticOrder, true, true>(lds3, g, S, E, tid); }
        else { EpiSwiglu<false> E{(bf16_t*)(ws + WS_H), RowScale<false>{RSg, rsl, rbase}}; pg8::gemm_phase<EpiSwiglu<false>, pg8::StaticOrder, true, true>(lds3, g, S, E, tid); } } SEAM(5);
    if (IN(6)) for (int rep_ = 0; rep_ <= ((PROBE_DUP_MASK >> 6) & 1); ++rep_) { if (rep_) __syncthreads(); FRESH(); pg8::Gemm g{(const bf16_t*)(ws + WS_H), (const bf16_t*)(ws + WS_WD0), T, 1024, DFF}; pg8::StaticOrder S; S.init(T, 1024, G, bx); EpiPlain E{Mb, 1024};
        pg8::gemm_phase<EpiPlain, pg8::StaticOrder, true, true>(lds3, g, S, E, tid); } SEAM(6);
    if (IN(7)) for (int rep_ = 0; rep_ <= ((PROBE_DUP_MASK >> 7) & 1); ++rep_) { if (rep_) __syncthreads(); FRESH(); ew_phase<false, false>(Mb, nullptr, XN, XN, nullptr, a.in[I_FFN_POST], (float*)(ws + WS_RS), lane, wave); } SEAM(7);
    if (IN(8)) for (int rep_ = 0; rep_ <= ((PROBE_DUP_MASK >> 8) & 1); ++rep_) { if (rep_) __syncthreads(); FRESH(); pg8::Gemm g{XN, (const bf16_t*)(ws + WS_WIN1), T, 2048, 1024}; pg8::StaticOrder S; S.init(T, 2048, G, bx); if (rs_in_lds) { RS_TO_LDS(); EpiOddIn<true> E{(bf16_t*)(ws + WS_G), (bf16_t*)(ws + WS_XR), RowScale<true>{RSg, rsl, rbase}}; pg8::gemm_phase<EpiOddIn<true>, pg8::StaticOrder, true, true>(lds3, g, S, E, tid); }
        else { EpiOddIn<false> E{(bf16_t*)(ws + WS_G), (bf16_t*)(ws + WS_XR), RowScale<false>{RSg, rsl, rbase}}; pg8::gemm_phase<EpiOddIn<false>, pg8::StaticOrder, true, true>(lds3, g, S, E, tid); } } SEAM(8);
    if (IN(9)) for (int rep_ = 0; rep_ <= ((PROBE_DUP_MASK >> 9) & 1); ++rep_) { if (rep_) __syncthreads(); FRESH(); conv_phase(a, tid); } SEAM(9);
    if (IN(10)) for (int rep_ = 0; rep_ <= ((PROBE_DUP_MASK >> 10) & 1); ++rep_) { if (rep_) __syncthreads(); FRESH(); int kg = 256; asm volatile("" : "+s"(kg)); pg8::Gemm g{(const bf16_t*)(ws + WS_XC), (const bf16_t*)(ws + WS_WAX), 4 * T, 2048, kg}; GatesOrder S{G, bx};
        EpiGates E{(const bf16_t*)(ws + WS_XC), a.in[I_OD_BA], a.in[I_OD_BX], (const float*)(ws + WS_LU), (bf16_t*)(ws + WS_A32), (bf16_t*)(ws + WS_BV)};
        pg8::gemm_phase<EpiGates, GatesOrder, true, true>(lds3, g, S, E, tid); } SEAM(10);
    if (IN(11)) for (int rep_ = 0; rep_ <= ((PROBE_DUP_MASK >> 11) & 1); ++rep_) { if (rep_) __syncthreads(); FRESH(); scan1_phase(a, tid); } SEAM(11);
    if (IN(12)) for (int rep_ = 0; rep_ <= ((PROBE_DUP_MASK >> 12) & 1); ++rep_) { if (rep_) __syncthreads(); FRESH(); scan2_phase(a, tid); } SEAM(12);
    if (IN(13)) for (int rep_ = 0; rep_ <= ((PROBE_DUP_MASK >> 13) & 1); ++rep_) { if (rep_) __syncthreads(); FRESH(); pg8::Gemm g{(const bf16_t*)(ws + WS_YG), (const bf16_t*)(ws + WS_WOUT1), T, 1024, 1024}; pg8::StaticOrder S; S.init(T, 1024, G, bx); EpiPlain E{Mb, 1024};
        pg8::gemm_phase<EpiPlain, pg8::StaticOrder, true, true>(lds3, g, S, E, tid); } SEAM(13);
    if (IN(14)) for (int rep_ = 0; rep_ <= ((PROBE_DUP_MASK >> 14) & 1); ++rep_) { if (rep_) __syncthreads(); FRESH(); ew_phase<false, false>(Mb, nullptr, XN, XN, nullptr, a.in[I_MIX_POST] + 1024, (float*)(ws + WS_RS), lane, wave); } SEAM(14);
    if (IN(15)) for (int rep_ = 0; rep_ <= ((PROBE_DUP_MASK >> 15) & 1); ++rep_) { if (rep_) __syncthreads(); FRESH(); pg8::Gemm g{XN, (const bf16_t*)(ws + WS_WGU1), T, 2 * DFF, 1024}; pg8::StaticOrder S; S.init(T, 2 * DFF, G, bx); if (rs_in_lds) { RS_TO_LDS(); EpiSwiglu<true> E{(bf16_t*)(ws + WS_H), RowScale<true>{RSg, rsl, rbase}}; pg8::gemm_phase<EpiSwiglu<true>, pg8::StaticOrder, true, true>(lds3, g, S, E, tid); }
        else { EpiSwiglu<false> E{(bf16_t*)(ws + WS_H), RowScale<false>{RSg, rsl, rbase}}; pg8::gemm_phase<EpiSwiglu<false>, pg8::StaticOrder, true, true>(lds3, g, S, E, tid); } } SEAM(15);
    if (IN(16)) for (int rep_ = 0; rep_ <= ((PROBE_DUP_MASK >> 16) & 1); ++rep_) { if (rep_) __syncthreads(); FRESH(); pg8::Gemm g{(const bf16_t*)(ws + WS_H), (const bf16_t*)(ws + WS_WD1), T, 1024, DFF}; pg8::StaticOrder S; S.init(T, 1024, G, bx); EpiPlain E{Mb, 1024};
        pg8::gemm_phase<EpiPlain, pg8::StaticOrder, true, true>(lds3, g, S, E, tid); } SEAM(16);
    if (IN(17)) for (int rep_ = 0; rep_ <= ((PROBE_DUP_MASK >> 17) & 1); ++rep_) { if (rep_) __syncthreads(); FRESH(); ew_phase<false, true>(Mb, nullptr, XN, XN, a.out, a.in[I_FFN_POST] + 1024, nullptr, lane, wave); }
#undef IN
#undef SEAM
}
extern "C" void kernel_launch(void* const* d_in, const int* in_sizes, int n_in, void* d_out, int out_size, void* d_ws, size_t ws_size, hipStream_t stream) {
    static int grid = 0;
    if (grid == 0) {
        if (n_in != 22 || out_size != T * DM || ws_size < WS_END) { fprintf(stderr, "kernel_launch: unexpected problem (n_in %d out %d ws %zu)\n", n_in, out_size, ws_size); grid = -1; return; }
        int dev = 0, cus = 0, per_cu = 0;
        hipGetDevice(&dev); hipDeviceGetAttribute(&cus, hipDeviceAttributeMultiprocessorCount, dev);
        if (hipFuncSetAttribute((const void*)fwd_mega, hipFuncAttributeMaxDynamicSharedMemorySize, LDS_BYTES) != hipSuccess) { fprintf(stderr, "kernel_launch: hipFuncSetAttribute failed\n"); grid = -1; return; }
        if (hipOccupancyMaxActiveBlocksPerMultiprocessor(&per_cu, (const void*)fwd_mega, 512, LDS_BYTES) != hipSuccess || per_cu < 1) { fprintf(stderr, "kernel_launch: occupancy query says %d\n", per_cu); per_cu = 1; }
        (void)hipGetLastError();
        grid = cus * per_cu;
    }
    if (grid < 0) return;
    Args a{};
    for (int i = 0; i < 22; ++i) a.in[i] = (const float*)d_in[i];
    a.out = (float*)d_out; a.ws = (unsigned char*)d_ws;
#if MK_PER_PHASE
    for (int p = 0; p < NPHASE; ++p) { a.ph_lo = p; a.ph_hi = p + 1; hipLaunchKernelGGL(fwd_mega, dim3(grid), dim3(512), LDS_BYTES, stream, a); }
#else
    a.ph_lo = 0; a.ph_hi = NPHASE;
    void* args[] = {&a};
    hipError_t e = hipLaunchCooperativeKernel((const void*)fwd_mega, dim3(grid), dim3(512), args, LDS_BYTES, stream);
    if (e != hipSuccess) fprintf(stderr, "kernel_launch: cooperative launch failed: %s (grid %d)\n", hipGetErrorString(e), grid);
#endif
}
```
